# Optimizing an MI355X kernel written in HIP

```python
import math
import numpy as np
import jax
import jax.numpy as jnp
from jax import lax

D_MODEL = 2048
BATCH = 8
SEQ = 2048
DEPTH = 2

HEAD_DIM = 128
NSA_HEADS = D_MODEL // (2 * HEAD_DIM)
NSA_KV_HEADS = 2
NSA_GROUP = NSA_HEADS // NSA_KV_HEADS
DIFF_VDIM = 2 * HEAD_DIM
DIFF_HEADS = D_MODEL // (2 * DIFF_VDIM)
CMP_LEN = 32
CMP_STRIDE = 16
CMP_HIDDEN = 256
SLC_LEN = 64
SLC_TOPK = 16
WINDOW = 512
D_FF = 5632
Q_BLOCK = 128
ROPE_THETA = 10000.0
EPS = 1e-6
NEG = -1e30

SPLIT_SIZES = (NSA_HEADS * HEAD_DIM,
               NSA_KV_HEADS * HEAD_DIM, NSA_KV_HEADS * HEAD_DIM,
               NSA_KV_HEADS * HEAD_DIM, NSA_KV_HEADS * HEAD_DIM,
               NSA_KV_HEADS * HEAD_DIM, NSA_KV_HEADS * HEAD_DIM,
               3 * NSA_HEADS,
               2 * DIFF_HEADS * HEAD_DIM, 2 * DIFF_HEADS * HEAD_DIM,
               DIFF_HEADS * DIFF_VDIM)
IN_WIDTH = sum(SPLIT_SIZES)

kernel_name = 'hybrid_nsa_diff_macaron'


def _rmsnorm(x, g):
    xf = x.astype(jnp.float32)
    y = xf * lax.rsqrt(jnp.mean(xf * xf, axis=-1, keepdims=True) + EPS)
    return (y * g.astype(jnp.float32)).astype(x.dtype)


def _swiglu(h, w_gate, w_up, w_down):
    return (jax.nn.silu(h @ w_gate) * (h @ w_up)) @ w_down


def _rope_tables(T):
    inv = 1.0 / (ROPE_THETA ** (jnp.arange(0, HEAD_DIM, 2, dtype=jnp.float32) / HEAD_DIM))
    ang = jnp.arange(T, dtype=jnp.float32)[:, None] * inv[None, :]
    ang = jnp.concatenate([ang, ang], axis=-1)
    return jnp.cos(ang), jnp.sin(ang)


def _rope(x, cos, sin):
    x1, x2 = jnp.split(x, 2, axis=-1)
    rot = jnp.concatenate([-x2, x1], axis=-1)
    return (x.astype(jnp.float32) * cos + rot.astype(jnp.float32) * sin).astype(x.dtype)


def _heads(t, n):
    B, T, _ = t.shape
    return t.reshape(B, T, n, -1).transpose(0, 2, 1, 3)


def _masked_softmax(s, mask):
    s = jnp.where(mask, s.astype(jnp.float32), NEG)
    return jax.nn.softmax(s, axis=-1) * mask


def _block_overlap(n_cmp, n_slc):
    c0 = np.arange(n_cmp) * CMP_STRIDE
    s0 = np.arange(n_slc) * SLC_LEN
    lo = np.maximum(c0[:, None], s0[None, :])
    hi = np.minimum(c0[:, None] + CMP_LEN, s0[None, :] + SLC_LEN)
    return (np.clip(hi - lo, 0, None) / CMP_LEN).astype(np.float32)


def _nsa(q, k_cmp, v_cmp, k_slc, v_slc, k_win, v_win, gates,
         pos_k, pos_v, wk1, wk2, wv1, wv2):
    B, G, R, T, dk = q.shape
    scale = dk ** -0.5
    n_cmp = (T - CMP_LEN) // CMP_STRIDE + 1
    n_slc = T // SLC_LEN
    n_sel = min(SLC_TOPK, n_slc)
    n_qb = T // Q_BLOCK
    t_pos = jnp.arange(T)

    win_idx = jnp.arange(n_cmp)[:, None] * CMP_STRIDE + jnp.arange(CMP_LEN)[None, :]

    def compress(kv, pos, w1, w2):
        blocks = kv[:, :, win_idx, :] + pos
        flat = blocks.reshape(B, G, n_cmp, CMP_LEN * dk)
        return jax.nn.silu(flat @ w1) @ w2

    kc = compress(k_cmp, pos_k, wk1, wk2)
    vc = compress(v_cmp, pos_v, wv1, wv2)
    s_c = jnp.einsum('bgrtd,bgnd->bgrtn', q, kc) * scale
    c_end = jnp.arange(n_cmp) * CMP_STRIDE + CMP_LEN - 1
    c_mask = c_end[None, :] <= t_pos[:, None]
    p_c = _masked_softmax(s_c, c_mask)
    o_cmp = jnp.einsum('bgrtn,bgnd->bgrtd', p_c.astype(vc.dtype), vc)

    overlap = jnp.asarray(_block_overlap(n_cmp, n_slc), dtype=jnp.float32)
    imp = jnp.einsum('bgrtn,ns->bgts', p_c, overlap)
    blk = jnp.arange(n_slc)
    cur = t_pos // SLC_LEN
    forced = (blk[None, :] == 0) | (blk[None, :] == cur[:, None]) | (blk[None, :] == cur[:, None] - 1)
    causal_blk = blk[None, :] * SLC_LEN <= t_pos[:, None]
    imp = jnp.where(forced, 1e4, imp)
    imp = jnp.where(causal_blk, imp, -1.0)
    top_val, top_idx = lax.top_k(imp, n_sel)
    top_ok = top_val >= 0.0

    kb = k_slc.reshape(B, G, n_slc, SLC_LEN, dk)
    vb = v_slc.reshape(B, G, n_slc, SLC_LEN, dk)

    def sel_block(i):
        b = i // n_qb
        s0 = (i % n_qb) * Q_BLOCK
        qi = lax.dynamic_slice(q, (b, 0, 0, s0, 0), (1, G, R, Q_BLOCK, dk))[0]
        ii = lax.dynamic_slice(top_idx, (b, 0, s0, 0), (1, G, Q_BLOCK, n_sel))[0]
        ok = lax.dynamic_slice(top_ok, (b, 0, s0, 0), (1, G, Q_BLOCK, n_sel))[0]
        kbb = lax.dynamic_index_in_dim(kb, b, 0, keepdims=False)
        vbb = lax.dynamic_index_in_dim(vb, b, 0, keepdims=False)
        ks = jax.vmap(lambda kg, ig: kg[ig])(kbb, ii)
        vs = jax.vmap(lambda vg, ig: vg[ig])(vbb, ii)
        tq = s0 + jnp.arange(Q_BLOCK)
        kpos = ii[..., None] * SLC_LEN + jnp.arange(SLC_LEN)
        mask = ok[..., None] & (kpos <= tq[None, :, None, None])
        mask = mask.reshape(G, 1, Q_BLOCK, n_sel * SLC_LEN)
        s = jnp.einsum('grqd,gqnld->grqnl', qi, ks) * scale
        p = _masked_softmax(s.reshape(G, R, Q_BLOCK, n_sel * SLC_LEN), mask)
        p = p.reshape(G, R, Q_BLOCK, n_sel, SLC_LEN)
        return jnp.einsum('grqnl,gqnld->grqd', p.astype(vs.dtype), vs)

    o = lax.map(sel_block, jnp.arange(B * n_qb))
    o_slc = o.reshape(B, n_qb, G, R, Q_BLOCK, dk).transpose(0, 2, 3, 1, 4, 5).reshape(B, G, R, T, dk)

    kp = jnp.pad(k_win, ((0, 0), (0, 0), (WINDOW, 0), (0, 0)))
    vp = jnp.pad(v_win, ((0, 0), (0, 0), (WINDOW, 0), (0, 0)))
    span = WINDOW + Q_BLOCK

    def win_block(j):
        s0 = j * Q_BLOCK
        qi = lax.dynamic_slice_in_dim(q, s0, Q_BLOCK, axis=3)
        ki = lax.dynamic_slice_in_dim(kp, s0, span, axis=2)
        vi = lax.dynamic_slice_in_dim(vp, s0, span, axis=2)
        tq = s0 + jnp.arange(Q_BLOCK)
        tk = s0 - WINDOW + jnp.arange(span)
        dist = tq[:, None] - tk[None, :]
        mask = (tk[None, :] >= 0) & (dist >= 0) & (dist < WINDOW)
        s = jnp.einsum('bgrqd,bgkd->bgrqk', qi, ki) * scale
        p = _masked_softmax(s, mask)
        return jnp.einsum('bgrqk,bgkd->bgrqd', p.astype(vi.dtype), vi)

    o = lax.map(win_block, jnp.arange(n_qb))
    o_win = o.transpose(1, 2, 3, 0, 4, 5).reshape(B, G, R, T, dk)

    g = gates.reshape(B, T, G, R, 3).transpose(0, 2, 3, 1, 4)
    out = g[..., 0:1] * o_cmp + g[..., 1:2] * o_slc + g[..., 2:3] * o_win
    return out.astype(q.dtype).transpose(0, 3, 1, 2, 4).reshape(B, T, G * R * dk)


def _diff_attn(q, k, v, lam_q1, lam_k1, lam_q2, lam_k2, subln_g, lambda_init):
    B, Hd, _, T, dk = q.shape
    scale = dk ** -0.5
    n_qb = T // Q_BLOCK
    f32 = jnp.float32
    lam = (jnp.exp(jnp.sum(lam_q1.astype(f32) * lam_k1.astype(f32)))
           - jnp.exp(jnp.sum(lam_q2.astype(f32) * lam_k2.astype(f32))) + lambda_init)
    t_k = jnp.arange(T)

    def blk(j):
        s0 = j * Q_BLOCK
        qi = lax.dynamic_slice_in_dim(q, s0, Q_BLOCK, axis=3)
        s = jnp.einsum('bhcqd,bhckd->bhcqk', qi, k) * scale
        mask = t_k[None, :] <= (s0 + jnp.arange(Q_BLOCK))[:, None]
        p = _masked_softmax(s, mask)
        a = p[:, :, 0] - lam * p[:, :, 1]
        return jnp.einsum('bhqk,bhkd->bhqd', a.astype(v.dtype), v)

    o = lax.map(blk, jnp.arange(n_qb))
    o = o.transpose(1, 2, 0, 3, 4).reshape(B, Hd, T, 2 * dk)
    o = (_rmsnorm(o, subln_g) * (1.0 - lambda_init)).astype(v.dtype)
    return o.transpose(0, 2, 1, 3).reshape(B, T, Hd * 2 * dk)


def _token_mix(h, w_in, pos_k, pos_v, wk1, wk2, wv1, wv2,
               lam_q1, lam_k1, lam_q2, lam_k2, subln_g, w_out, lambda_init, cos, sin):
    B, T, _ = h.shape
    proj = h @ w_in
    cuts = [int(c) for c in np.cumsum(SPLIT_SIZES)[:-1]]
    (q_n, kc, vc, ks, vs, kw, vw, g, q_d, k_d, v_d) = jnp.split(proj, cuts, axis=-1)
    G, R = NSA_KV_HEADS, NSA_GROUP
    qn = _rope(_heads(q_n, NSA_HEADS), cos, sin).reshape(B, G, R, T, HEAD_DIM)
    kc = _rope(_heads(kc, G), cos, sin)
    ks = _rope(_heads(ks, G), cos, sin)
    kw = _rope(_heads(kw, G), cos, sin)
    gates = jax.nn.sigmoid(g.astype(jnp.float32)).reshape(B, T, NSA_HEADS, 3)
    o_nsa = _nsa(qn, kc, _heads(vc, G), ks, _heads(vs, G), kw, _heads(vw, G), gates,
                 pos_k, pos_v, wk1, wk2, wv1, wv2)
    qd = _rope(_heads(q_d, 2 * DIFF_HEADS), cos, sin).reshape(B, DIFF_HEADS, 2, T, HEAD_DIM)
    kd = _rope(_heads(k_d, 2 * DIFF_HEADS), cos, sin).reshape(B, DIFF_HEADS, 2, T, HEAD_DIM)
    vd = _heads(v_d, DIFF_HEADS)
    o_diff = _diff_attn(qd, kd, vd, lam_q1, lam_k1, lam_q2, lam_k2, subln_g, lambda_init)
    return jnp.concatenate([o_nsa, o_diff], axis=-1) @ w_out


def setup_inputs(seed: int = 0) -> dict:
    key = jax.random.key(seed)
    ks = jax.random.split(key, 24)
    f32 = jnp.float32

    def nrm(k, shape, scale):
        return jax.random.normal(k, shape, f32) * scale

    def gain(k, shape):
        return 1.0 + 0.05 * jax.random.normal(k, shape, f32)

    L, D = DEPTH, D_MODEL
    cin = CMP_LEN * HEAD_DIM
    return {
        'x': nrm(ks[0], (BATCH, SEQ, D), 1.0),
        'ffn1_norm': gain(ks[1], (L, D)),
        'ffn1_w_gate': nrm(ks[2], (L, D, D_FF), D ** -0.5),
        'ffn1_w_up': nrm(ks[3], (L, D, D_FF), D ** -0.5),
        'ffn1_w_down': nrm(ks[4], (L, D_FF, D), D_FF ** -0.5),
        'mix_norm': gain(ks[5], (L, D)),
        'w_in': nrm(ks[6], (L, D, IN_WIDTH), D ** -0.5),
        'cmp_pos_k': nrm(ks[7], (L, CMP_LEN, HEAD_DIM), 0.1),
        'cmp_pos_v': nrm(ks[8], (L, CMP_LEN, HEAD_DIM), 0.1),
        'cmp_wk1': nrm(ks[9], (L, cin, CMP_HIDDEN), cin ** -0.5),
        'cmp_wk2': nrm(ks[10], (L, CMP_HIDDEN, HEAD_DIM), CMP_HIDDEN ** -0.5),
        'cmp_wv1': nrm(ks[11], (L, cin, CMP_HIDDEN), cin ** -0.5),
        'cmp_wv2': nrm(ks[12], (L, CMP_HIDDEN, HEAD_DIM), CMP_HIDDEN ** -0.5),
        'lam_q1': nrm(ks[13], (L, HEAD_DIM), 0.1),
        'lam_k1': nrm(ks[14], (L, HEAD_DIM), 0.1),
        'lam_q2': nrm(ks[15], (L, HEAD_DIM), 0.1),
        'lam_k2': nrm(ks[16], (L, HEAD_DIM), 0.1),
        'diff_subln': gain(ks[17], (L, DIFF_VDIM)),
        'w_out': nrm(ks[18], (L, D, D), D ** -0.5),
        'ffn2_norm': gain(ks[19], (L, D)),
        'ffn2_w_gate': nrm(ks[20], (L, D, D_FF), D ** -0.5),
        'ffn2_w_up': nrm(ks[21], (L, D, D_FF), D ** -0.5),
        'ffn2_w_down': nrm(ks[22], (L, D_FF, D), D_FF ** -0.5),
        'final_norm': gain(ks[23], (D,)),
    }


def reference(x, ffn1_norm, ffn1_w_gate, ffn1_w_up, ffn1_w_down, mix_norm, w_in,
              cmp_pos_k, cmp_pos_v, cmp_wk1, cmp_wk2, cmp_wv1, cmp_wv2,
              lam_q1, lam_k1, lam_q2, lam_k2, diff_subln, w_out,
              ffn2_norm, ffn2_w_gate, ffn2_w_up, ffn2_w_down, final_norm):
    T = x.shape[1]
    cos, sin = _rope_tables(T)
    for l in range(DEPTH):
        lambda_init = 0.8 - 0.6 * math.exp(-0.3 * l)
        x = x + 0.5 * _swiglu(_rmsnorm(x, ffn1_norm[l]), ffn1_w_gate[l], ffn1_w_up[l], ffn1_w_down[l])
        h = _rmsnorm(x, mix_norm[l])
        x = x + _token_mix(h, w_in[l], cmp_pos_k[l], cmp_pos_v[l], cmp_wk1[l], cmp_wk2[l],
                           cmp_wv1[l], cmp_wv2[l], lam_q1[l], lam_k1[l], lam_q2[l], lam_k2[l],
                           diff_subln[l], w_out[l], lambda_init, cos, sin)
        x = x + 0.5 * _swiglu(_rmsnorm(x, ffn2_norm[l]), ffn2_w_gate[l], ffn2_w_up[l], ffn2_w_down[l])
    return _rmsnorm(x, final_norm)
```

```cpp
#include <hip/hip_runtime.h>
#include <hip/hip_bf16.h>
#include <hip/hip_cooperative_groups.h>
#include <cstdio>
#include <cstdint>
namespace cg = cooperative_groups;
__device__ __forceinline__ int opaque_tid() { int t = threadIdx.x; asm volatile("" : "+v"(t)); return t; }

constexpr int M_TOK = 16384, DM = 2048, DFF = 5632, LDP = 5632, NPROJ = 5888, TSEQ = 2048;
__host__ __device__ constexpr bool is_rope_tile(int pn) { return pn <= 4 || pn == 6 || pn == 8 || (pn >= 10 && pn < 18); }

namespace pg8 {
#define PG8_LAS __attribute__((address_space(3)))
typedef unsigned short bf16_t;
typedef short bf16x8 __attribute__((ext_vector_type(8)));
typedef float f32x4 __attribute__((ext_vector_type(4)));
typedef unsigned u32x4 __attribute__((ext_vector_type(4)));
constexpr int BM = 256, BK = 64, HALF = 128, HTB = HALF * BK * 2  , STAGE_BYTES = 8 * HTB, NXCD = 8, WGM = 8;

__host__ __device__ __forceinline__ int lds_byte(int r, int c) { const int st = (r >> 4) * 2 + (c >> 5), rr = r & 15, cc = c & 31, ob = rr * 64 + cc * 2; return st * 1024 + (ob ^ (((ob >> 9) & 1) << 5)); }
__host__ __device__ __forceinline__ void stage_rc(int b, int& R, int& C) { const int st = b / 1024, sb = b % 1024, swz = sb ^ (((sb >> 9) & 1) << 5); R = (st >> 1) * 16 + swz / 64; C = (st & 1) * 32 + (swz % 64) / 2; }
__host__ __device__ __forceinline__ int perm32(int rho) { const int n = rho >> 4, i = rho & 15; return 8 * (i >> 2) + 4 * n + (i & 3); }

struct Unit { int pm, pn; };
struct Gemm { const bf16_t* A; const bf16_t* Bt; int M, N, K; };

struct StaticOrder {
    int nM, nN, nwg, G, c;
    __host__ __device__ void init(int M, int N, int G_, int c_) { nM = M / BM; nN = N / BM; nwg = nM * nN; G = G_; c = c_; }
    __host__ __device__ bool next(int i, Unit& u) const {
        const long L = (long)i * G + c; if (L >= nwg) return false;
        int wgid = (int)L; { const int q = nwg / NXCD, r = nwg % NXCD, xcd = wgid % NXCD, off = wgid / NXCD; wgid = (xcd < r ? xcd * (q + 1) : r * (q + 1) + (xcd - r) * q) + off; }
        const int nig = WGM * nN, gid = wgid / nig, fm = gid * WGM, gsz = (nM - fm) < WGM ? (nM - fm) : WGM;
        u.pm = fm + ((wgid % nig) % gsz); u.pn = (wgid % nig) / gsz; return true;
    }
    __device__ __forceinline__ void a_ready(const Unit&) const {}
    __device__ __forceinline__ void done(const Unit&) const {}
};
__device__ __forceinline__ unsigned cvt_pk_bf16(float lo, float hi) { unsigned r; asm volatile("v_cvt_pk_bf16_f32 %0, %1, %2" : "=v"(r) : "v"(lo), "v"(hi)); return r; }
typedef float f32x2 __attribute__((ext_vector_type(2)));
__device__ __forceinline__ float silu_f(float x) { return x * __builtin_amdgcn_rcpf(1.0f + __builtin_amdgcn_exp2f(-1.4426950408889634f * x)); }
__device__ __forceinline__ float sigmoid_f(float x) { return __builtin_amdgcn_rcpf(1.0f + __builtin_amdgcn_exp2f(-1.4426950408889634f * x)); }
__device__ __forceinline__ u32x4 pack8_bf16(f32x4 a, f32x4 b) { u32x4 w; w.x = cvt_pk_bf16(a[0], a[1]); w.y = cvt_pk_bf16(a[2], a[3]); w.z = cvt_pk_bf16(b[0], b[1]); w.w = cvt_pk_bf16(b[2], b[3]); return w; }

struct EpiSwiGLU {
    static constexpr bool PERM = true, AFTER_DRAIN = false;
    bf16_t* O; int ldc;
    __device__ __forceinline__ void operator()(const f32x4 (&acc)[2][2][4][2], const Unit& u, int wr, int wc, int fr, int fq) const {
        const int row0 = u.pm * BM + wr * 64 + fr, col0 = u.pn * 128 + wc * 32 + 8 * fq;
#pragma unroll
        for (int ai = 0; ai < 2; ++ai)
#pragma unroll
            for (int m = 0; m < 4; ++m) {
                bf16_t* rowp = O + (size_t)(row0 + ai * HALF + m * 16) * ldc + col0;
                f32x4 v0, v1;
#pragma unroll
                for (int j = 0; j < 4; ++j) { v0[j] = silu_f(acc[ai][0][m][0][j]) * acc[ai][1][m][0][j]; v1[j] = silu_f(acc[ai][0][m][1][j]) * acc[ai][1][m][1][j]; }
                *(u32x4*)rowp = pack8_bf16(v0, v1);
            }
    }
};
struct EpiRes {
    static constexpr bool PERM = false, AFTER_DRAIN = false;
    const float* base; float* out; int ldc; float scale;
    __device__ __forceinline__ void operator()(const f32x4 (&acc)[2][2][4][2], const Unit& u, int wr, int wc, int fr, int fq) const {
        const int row0 = u.pm * BM + wr * 64 + fr, col0 = u.pn * BM + wc * 32 + 4 * fq;
#pragma unroll
        for (int ai = 0; ai < 2; ++ai)
#pragma unroll
            for (int m = 0; m < 4; ++m) { const size_t off = (size_t)(row0 + ai * HALF + m * 16) * ldc + col0;
#pragma unroll
                for (int bj = 0; bj < 2; ++bj)
#pragma unroll
                    for (int n = 0; n < 2; ++n) { const f32x4 b = *(const f32x4*)(base + off + bj * HALF + n * 16); *(f32x4*)(out + off + bj * HALF + n * 16) = b + acc[ai][bj][m][n] * scale; }
                asm volatile("" ::: "memory"); }
    }
};
struct EpiProj {
    static constexpr bool PERM = true, AFTER_DRAIN = false;
    bf16_t* P; float* gates; const float* rc; const float* rs;
    __device__ __forceinline__ void operator()(const f32x4 (&acc)[2][2][4][2], const Unit& u, int wr, int wc, int fr, int fq) const {
        const int row0 = u.pm * BM + wr * 64 + fr, pn = u.pn;
        if (pn == 22) {
            if (wc == 0 && fq < 3) {
#pragma unroll
                for (int ai = 0; ai < 2; ++ai)
#pragma unroll
                    for (int m = 0; m < 4; ++m) { float* gp = gates + (size_t)(row0 + ai * HALF + m * 16) * 32 + 8 * fq;
#pragma unroll
                        for (int n = 0; n < 2; ++n) { f32x4 v;
#pragma unroll
                            for (int j = 0; j < 4; ++j) v[j] = sigmoid_f(acc[ai][0][m][n][j]);
                            *(f32x4*)(gp + 4 * n) = v; } }
            }
        } else if (is_rope_tile(pn)) {
            const int hp = wc >> 1, d0 = 32 * (wc & 1) + 8 * fq;
#pragma unroll
            for (int ai = 0; ai < 2; ++ai)
#pragma unroll
                for (int m = 0; m < 4; ++m) { const int row = row0 + ai * HALF + m * 16, t = row & (TSEQ - 1);
                    const f32x4 c0 = *(const f32x4*)(rc + t * 64 + d0), c1 = *(const f32x4*)(rc + t * 64 + d0 + 4), s0 = *(const f32x4*)(rs + t * 64 + d0), s1 = *(const f32x4*)(rs + t * 64 + d0 + 4);
                    const f32x4 x1a = acc[ai][0][m][0], x1b = acc[ai][0][m][1], x2a = acc[ai][1][m][0], x2b = acc[ai][1][m][1];
                    const f32x4 o1a = x1a * c0 - x2a * s0, o1b = x1b * c1 - x2b * s1, o2a = x2a * c0 + x1a * s0, o2b = x2b * c1 + x1b * s1;
                    bf16_t* pp = P + (size_t)row * LDP + pn * 256 + hp * 128 + d0;
                    *(u32x4*)pp = pack8_bf16(o1a, o1b); *(u32x4*)(pp + 64) = pack8_bf16(o2a, o2b); }
        } else {
#pragma unroll
            for (int ai = 0; ai < 2; ++ai)
#pragma unroll
                for (int m = 0; m < 4; ++m) { bf16_t* pp = P + (size_t)(row0 + ai * HALF + m * 16) * LDP + pn * 256 + wc * 32 + 8 * fq;
#pragma unroll
                    for (int bj = 0; bj < 2; ++bj) *(u32x4*)(pp + bj * HALF) = pack8_bf16(acc[ai][bj][m][0], acc[ai][bj][m][1]); }
        }
    }
};
struct EpiSiluH {
    static constexpr bool PERM = true, AFTER_DRAIN = false;
    bf16_t* H;
    __device__ __forceinline__ void operator()(const f32x4 (&acc)[2][2][4][2], const Unit& u, int wr, int wc, int fr, int fq) const {
        const int row0 = u.pm * BM + wr * 64 + fr;
#pragma unroll
        for (int ai = 0; ai < 2; ++ai)
#pragma unroll
            for (int m = 0; m < 4; ++m) { bf16_t* pp = H + (size_t)((row0 + ai * HALF + m * 16) & 2047) * 512 + u.pn * 256 + wc * 32 + 8 * fq;
#pragma unroll
                for (int bj = 0; bj < 2; ++bj) { f32x4 v0, v1;
#pragma unroll
                    for (int j = 0; j < 4; ++j) { v0[j] = silu_f(acc[ai][bj][m][0][j]); v1[j] = silu_f(acc[ai][bj][m][1][j]); }
                    *(u32x4*)(pp + bj * HALF) = pack8_bf16(v0, v1); } }
    }
};
struct EpiKCVC {
    static constexpr bool PERM = true, AFTER_DRAIN = false;
    bf16_t* KC; bf16_t* VCT;
    __device__ __forceinline__ void operator()(const f32x4 (&acc)[2][2][4][2], const Unit& u, int wr, int wc, int fr, int fq) const {
        const int row0 = u.pm * BM + wr * 64 + fr, c0 = wc * 32 + 8 * fq;
#pragma unroll
        for (int ai = 0; ai < 2; ++ai)
#pragma unroll
            for (int m = 0; m < 4; ++m) { const int row = row0 + ai * HALF + m * 16, bg = row >> 7, n = row & 127;
                *(u32x4*)(KC + (size_t)row * 128 + c0) = pack8_bf16(acc[ai][0][m][0], acc[ai][0][m][1]);
#pragma unroll
                for (int nn = 0; nn < 2; ++nn)
#pragma unroll
                    for (int j = 0; j < 4; ++j) { const float v = acc[ai][1][m][nn][j]; VCT[((size_t)bg * 128 + c0 + 4 * nn + j) * 128 + n] = (bf16_t)(cvt_pk_bf16(v, v) & 0xffffu); } }
    }
};
struct DiagOrder {
    int c;
    __device__ bool next(int i, Unit& u) const { if (i > 0 || c >= 16) return false; u.pm = c; u.pn = c >> 3; return true; }
    __device__ __forceinline__ void a_ready(const Unit&) const {}
    __device__ __forceinline__ void done(const Unit&) const {}
};
template <class Epi, class Sched, bool STAMP = false>
__device__ __forceinline__ void gemm_phase(PG8_LAS unsigned char* lds, const Gemm g, const Sched& S, const Epi& E, unsigned long long* stamps) {
    const int tid = opaque_tid(), wid = __builtin_amdgcn_readfirstlane(tid >> 6), lane = tid & 63, wr = wid >> 2, wc = wid & 3, fr = lane & 15, fq = lane >> 4;
    const int K = g.K, nt = K / BK;
    int ts_lo = 0, ts_hi = 0, nts = 0; const unsigned long long rt_entry = STAMP ? (unsigned long long)wall_clock64() : 0ull;
#define PG8_STAMP() do { if (STAMP && wid == 0 && nts < 64) { const unsigned long long _c = (unsigned long long)clock64(); \
        ts_lo = (lane == nts) ? (int)(unsigned)_c : ts_lo; ts_hi = (lane == nts) ? (int)(unsigned)(_c >> 32) : ts_hi; ++nts; } } while (0)
    PG8_STAMP();
    unsigned voffA[2], voffB[2];
#pragma unroll
    for (int i = 0; i < 2; ++i) { int R, C; stage_rc(tid * 16 + i * 8192, R, C); const int Rb = Epi::PERM ? ((R & ~31) + perm32(R & 31)) : R;
        voffA[i] = (unsigned)(R * K + C) * 2u; voffB[i] = (unsigned)(Rb * K + C) * 2u; }
    const size_t kstep = (size_t)(BK * 2);
    const size_t hstep = (size_t)HALF * K * 2;
    const size_t tstep = 2 * hstep;
    const unsigned ldsw = (unsigned)wid * 1024u;
    const int aoff = lds_byte(wr * 64 + fr, fq * 8), boff = lds_byte(wc * 32 + fr, fq * 8);
#define PG8_SA(b, h) (((b) * 2 + (h)) * HTB)
#define PG8_SB(b, h) ((4 + (b) * 2 + (h)) * HTB)
#define PG8_STAGE(bufoff, gbase, voff) do { _Pragma("unroll") for (int _i = 0; _i < 2; ++_i) \
        __builtin_amdgcn_global_load_lds((const unsigned*)((const char*)(gbase) + (voff)[_i]), (PG8_LAS unsigned*)(lds + (bufoff) + ldsw + _i * 8192), 16, 0, 0); } while (0)
#define PG8_LDA(dst, b, h) do { _Pragma("unroll") for (int m = 0; m < 4; ++m) _Pragma("unroll") for (int k = 0; k < 2; ++k) dst[m][k] = *(const PG8_LAS bf16x8*)(lds + PG8_SA(b, h) + aoff + m * 2048 + k * 1024); } while (0)
#define PG8_LDB(dst, b, h) do { _Pragma("unroll") for (int n = 0; n < 2; ++n) _Pragma("unroll") for (int k = 0; k < 2; ++k) dst[n][k] = *(const PG8_LAS bf16x8*)(lds + PG8_SB(b, h) + boff + n * 2048 + k * 1024); } while (0)
#define PG8_MMA(ai, bj, At, Bt) do { __builtin_amdgcn_s_setprio(1); _Pragma("unroll") for (int m = 0; m < 4; ++m) _Pragma("unroll") for (int n = 0; n < 2; ++n) _Pragma("unroll") for (int k = 0; k < 2; ++k) \
        acc[ai][bj][m][n] = __builtin_amdgcn_mfma_f32_16x16x32_bf16(Bt[n][k], At[m][k], acc[ai][bj][m][n], 0, 0, 0); __builtin_amdgcn_s_setprio(0); } while (0)
#define PG8_WAIT_V(n) asm volatile("s_waitcnt vmcnt(" #n ")" ::: "memory")
#define PG8_WAIT_L(n) asm volatile("s_waitcnt lgkmcnt(" #n ")" ::: "memory")
#define PG8_BAR __builtin_amdgcn_s_barrier()
#define PG8_SCHED __builtin_amdgcn_sched_barrier(0)
    Unit cur, nxt; int ui = 0;
    if (!S.next(0, cur)) return;
    f32x4 acc[2][2][4][2];
#pragma unroll
    for (int a = 0; a < 2; ++a)
#pragma unroll
        for (int b = 0; b < 2; ++b)
#pragma unroll
            for (int m = 0; m < 4; ++m)
#pragma unroll
                for (int n = 0; n < 2; ++n) acc[a][b][m][n] = (f32x4){0.f, 0.f, 0.f, 0.f};
    bf16x8 At[4][2], B0[2][2], B1[2][2];
    const char* cA = (const char*)g.A + (size_t)cur.pm * tstep; const char* cB = (const char*)g.Bt + (size_t)cur.pn * tstep;
    S.a_ready(cur);
    PG8_STAGE(PG8_SB(0, 0), cB, voffB); PG8_STAGE(PG8_SA(0, 0), cA, voffA); PG8_STAGE(PG8_SB(0, 1), cB + hstep, voffB); PG8_STAGE(PG8_SA(0, 1), cA + hstep, voffA);
    if (wr == 1) PG8_BAR;
    PG8_WAIT_V(4); PG8_BAR;
    PG8_STAGE(PG8_SB(1, 0), cB + kstep, voffB); PG8_STAGE(PG8_SA(1, 0), cA + kstep, voffA); PG8_STAGE(PG8_SB(1, 1), cB + hstep + kstep, voffB);
    PG8_WAIT_V(6); PG8_BAR;
    PG8_STAMP();
    for (;;) {
        const bool has_next = S.next(ui + 1, nxt);
        const char* nA = has_next ? (const char*)g.A + (size_t)nxt.pm * tstep : cA; const char* nB = has_next ? (const char*)g.Bt + (size_t)nxt.pn * tstep : cB;
        for (int t = 0; t < nt; t += 2) {
            const bool last = (t == nt - 2);
            const char* a1 = cA + (size_t)(t + 1) * kstep;
            const char* a2 = last ? nA : cA + (size_t)(t + 2) * kstep; const char* b2 = last ? nB : cB + (size_t)(t + 2) * kstep;
            const char* a3 = a2 + kstep; const char* b3 = b2 + kstep;
            if (last && has_next) S.a_ready(nxt);
            PG8_LDB(B0, 0, 0); PG8_SCHED; PG8_LDA(At, 0, 0); PG8_STAGE(PG8_SA(1, 1), a1 + hstep, voffA);
            PG8_WAIT_L(8); PG8_BAR; PG8_WAIT_L(0); PG8_MMA(0, 0, At, B0); PG8_BAR; PG8_SCHED;
            PG8_LDB(B1, 0, 1); PG8_STAGE(PG8_SB(0, 0), b2, voffB);
            PG8_BAR; PG8_WAIT_L(0); PG8_MMA(0, 1, At, B1); PG8_BAR;
            PG8_LDA(At, 0, 1); PG8_STAGE(PG8_SA(0, 0), a2, voffA);
            PG8_BAR; PG8_WAIT_L(0); PG8_MMA(1, 0, At, B0); PG8_BAR; PG8_SCHED;
            PG8_STAGE(PG8_SB(0, 1), b2 + hstep, voffB);
            PG8_WAIT_V(6); PG8_BAR; PG8_MMA(1, 1, At, B1); PG8_BAR;
            PG8_LDB(B0, 1, 0); PG8_SCHED; PG8_LDA(At, 1, 0); PG8_STAGE(PG8_SA(0, 1), a2 + hstep, voffA);
            PG8_WAIT_L(8); PG8_BAR; PG8_WAIT_L(0); PG8_MMA(0, 0, At, B0); PG8_BAR; PG8_SCHED;
            PG8_LDB(B1, 1, 1); PG8_STAGE(PG8_SB(1, 0), b3, voffB);
            PG8_BAR; PG8_WAIT_L(0); PG8_MMA(0, 1, At, B1); PG8_BAR;
            PG8_LDA(At, 1, 1); PG8_STAGE(PG8_SA(1, 0), a3, voffA);
            PG8_BAR; PG8_WAIT_L(0); PG8_MMA(1, 0, At, B0); PG8_BAR; PG8_SCHED;
            PG8_STAGE(PG8_SB(1, 1), b3 + hstep, voffB);
            PG8_WAIT_V(6); PG8_BAR; PG8_MMA(1, 1, At, B1); PG8_BAR;
        }
        PG8_STAMP();
        if constexpr (!Epi::AFTER_DRAIN) { E(acc, cur, wr, wc, fr, fq); S.done(cur); }
        PG8_STAMP();
        if (!has_next) break;
#pragma unroll
        for (int a = 0; a < 2; ++a)
#pragma unroll
            for (int b = 0; b < 2; ++b)
#pragma unroll
                for (int m = 0; m < 4; ++m)
#pragma unroll
                    for (int n = 0; n < 2; ++n) acc[a][b][m][n] = (f32x4){0.f, 0.f, 0.f, 0.f};
        cur = nxt; cA = nA; cB = nB; ++ui;
    }
    PG8_WAIT_V(0);
    if (wr == 0) PG8_BAR;
    PG8_BAR;
    if constexpr (Epi::AFTER_DRAIN) { E.fused(acc, cur, wr, wc, fr, fq, lds, wid, lane); S.done(cur); }
    PG8_STAMP();
    if (STAMP && wid == 0) { stamps[lane] = lane < nts ? (((unsigned long long)(unsigned)ts_hi << 32) | (unsigned)ts_lo) : 0ull;
        if (lane == 62) stamps[62] = rt_entry; if (lane == 63) stamps[63] = (unsigned long long)wall_clock64(); }
#undef PG8_STAMP
#undef PG8_SA
#undef PG8_SB
#undef PG8_STAGE
#undef PG8_LDA
#undef PG8_LDB
#undef PG8_MMA
#undef PG8_WAIT_V
#undef PG8_WAIT_L
#undef PG8_BAR
#undef PG8_SCHED
}
}
namespace att {
constexpr int D = 128; constexpr float THR = 8.f; constexpr bool WSKIP = false; constexpr int LDQ = LDP, LDK = LDP, LDO = 1024;
constexpr float SCALE = 0.08838834764831845f;
constexpr int NW = 8, QBLK = 32, KVBLK = 64, QB = NW * QBLK;
constexpr int SHM_V = KVBLK * D * 2, SHM_K = KVBLK * D * 2;
constexpr int LDS_BYTES = 2 * SHM_V + 2 * SHM_K + NW * 64 * 4;

using bf16 = __hip_bfloat16;
typedef short bf16x8 __attribute__((ext_vector_type(8)));
typedef short s16x4 __attribute__((ext_vector_type(4)));
typedef float f32x16 __attribute__((ext_vector_type(16)));
typedef float f32x4 __attribute__((ext_vector_type(4)));
typedef unsigned u32x4 __attribute__((ext_vector_type(4)));
template <class A, class Bt> struct same_t { static constexpr bool v = false; };
template <class A> struct same_t<A, A> { static constexpr bool v = true; };

#define KSWZ(row, colB) ((row) * 256 + ((colB) ^ (((row) & 7) << 4)))
#define SBAR() __builtin_amdgcn_sched_barrier(0)
__device__ __forceinline__ int v_st(int k, int c) { const int kk = (k & ~0xC) | ((k & 4) << 1) | ((k & 8) >> 1); return ((kk >> 3) * 4 + (c >> 5)) * 512 + ((kk & 7) * 32 + (c & 31)) * 2; }
__device__ __forceinline__ int v_rd_base(int lane) { return ((lane & 3) << 3) | (((lane >> 2) & 3) << 6) | (((lane >> 4) & 1) << 5) | (((lane >> 5) & 1) << 8); }
constexpr int v_rd_off(int d0, int ks, int half) { return d0 * 512 + ks * 4096 + half * 2048; }
__device__ __forceinline__ int crow(int r, int hi) { return (r & 3) + 8 * (r >> 2) + 4 * hi; }
__device__ __forceinline__ unsigned cvtpk(float lo, float hi) {
    unsigned r; asm volatile("v_cvt_pk_bf16_f32 %0, %1, %2" : "=v"(r) : "v"(lo), "v"(hi)); return r;
}
__device__ __forceinline__ bf16x8 pack8(f32x4 a, f32x4 b) {
    u32x4 w = {cvtpk(a[0], a[1]), cvtpk(a[2], a[3]), cvtpk(b[0], b[1]), cvtpk(b[2], b[3])};
    return *reinterpret_cast<bf16x8*>(&w);
}
template <class T> __device__ __forceinline__ bf16x8 load8(const T* p) {
    if constexpr (same_t<T, float>::v) { return pack8(*(const f32x4*)p, *(const f32x4*)(p + 4)); }
    else { return *reinterpret_cast<const bf16x8*>(p); }
}
__device__ __forceinline__ void mask_tile(f32x16& p0, f32x16& p1, int dq, unsigned W) {
    const float NEG = -__builtin_inff();
#pragma unroll
    for (int r = 0; r < 16; ++r) {
        const int c = (r & 3) + 8 * (r >> 2);
        if ((unsigned)(dq - c) >= W) p0[r] = NEG;
        if ((unsigned)(dq - c - 32) >= W) p1[r] = NEG;
    }
}
__device__ __forceinline__ void partialSM(f32x16& p0, f32x16& p1, float& m_reg, float& mn, float& alpha) {
    float pmax = p0[0]; for (int r = 1; r < 16; ++r) pmax = fmaxf(pmax, p0[r]); for (int r = 0; r < 16; ++r) pmax = fmaxf(pmax, p1[r]);
    { auto rr = __builtin_amdgcn_permlane32_swap(__float_as_uint(pmax), __float_as_uint(pmax), false, false);
      pmax = fmaxf(__uint_as_float(rr[0]), __uint_as_float(rr[1])); }
    constexpr float C2 = 1.4426950408889634f * SCALE;
    if (__builtin_expect(__all((pmax - m_reg) * SCALE <= THR), 1)) { mn = m_reg; alpha = 1.f; }
    else { mn = fmaxf(m_reg, pmax); alpha = __builtin_amdgcn_exp2f((m_reg - mn) * C2); m_reg = mn; }
    const float mnL = -mn * C2;
    for (int r = 0; r < 16; ++r) p0[r] = fmaf(p0[r], C2, mnL); for (int r = 0; r < 16; ++r) p1[r] = fmaf(p1[r], C2, mnL);
    for (int r = 0; r < 16; ++r) p0[r] = __builtin_amdgcn_exp2f(p0[r]);
}
__device__ __forceinline__ void finishSM(f32x16& p0, f32x16& p1, float alpha, float& l_reg, bf16x8& pa0, bf16x8& pa1, bf16x8& pa2, bf16x8& pa3) {
    for (int r = 0; r < 16; ++r) p1[r] = __builtin_amdgcn_exp2f(p1[r]);
    float ps = 0; for (int r = 0; r < 16; ++r) ps += p0[r]; for (int r = 0; r < 16; ++r) ps += p1[r];
    { auto rr = __builtin_amdgcn_permlane32_swap(__float_as_uint(ps), __float_as_uint(ps), false, false);
      ps = __uint_as_float(rr[0]) + __uint_as_float(rr[1]); }
    l_reg = l_reg * alpha + ps;
#define PK4(P, B_, OUT) do { unsigned a0 = cvtpk(P[B_+0], P[B_+1]), a1 = cvtpk(P[B_+2], P[B_+3]);                          \
        unsigned b0 = cvtpk(P[B_+4], P[B_+5]), b1 = cvtpk(P[B_+6], P[B_+7]);                                             \
        auto r0 = __builtin_amdgcn_permlane32_swap(a0, b0, false, false); auto r1 = __builtin_amdgcn_permlane32_swap(a1, b1, false, false); \
        u32x4 w = {r0[0], r1[0], r0[1], r1[1]}; OUT = *reinterpret_cast<bf16x8*>(&w); } while (0)
    PK4(p0, 0, pa0); PK4(p0, 8, pa1); PK4(p1, 0, pa2); PK4(p1, 8, pa3);
#undef PK4
}
template <int KB, bool SK>
__device__ __forceinline__ void qkt(f32x16& p0, f32x16& p1, const char* K_lds, int r32, int hi, const bf16x8* qr, bool act) {
    if (SK && !act) { const float NEG = -__builtin_inff();
#pragma unroll
        for (int r = 0; r < 16; ++r) { p0[r] = NEG; p1[r] = NEG; } return; }
    p0 = f32x16{}; p1 = f32x16{};
    const char* kb[4];
#pragma unroll
    for (int dd = 0; dd < 4; ++dd) kb[dd] = K_lds + KB * SHM_K + KSWZ(r32, (dd * 16 + hi * 8) * 2);
#pragma unroll
    for (int d0 = 0; d0 < 8; ++d0) { const char* a = kb[d0 & 3] + (d0 >> 2) * 128;
        bf16x8 b0 = *reinterpret_cast<const bf16x8*>(a);
        bf16x8 b1 = *reinterpret_cast<const bf16x8*>(a + 32 * 256);
        p0 = __builtin_amdgcn_mfma_f32_32x32x16_bf16(b0, qr[d0], p0, 0, 0, 0);
        p1 = __builtin_amdgcn_mfma_f32_32x32x16_bf16(b1, qr[d0], p1, 0, 0, 0); }
}
template <int VB, bool SK>
__device__ __forceinline__ void pv_tile(f32x16* o, int vb0, bf16x8 pa0, bf16x8 pa1, bf16x8 pa2, bf16x8 pa3, bool act) {
    if (SK && !act) return;
#define TRRD(dst, off) asm volatile("ds_read_b64_tr_b16 %0, %1 offset:%2" : "=&v"(dst) : "v"(vb0), "i"(off) : "memory")
#define PV_D0(d0) do { s16x4 l0, l1, l2, l3, h0, h1, h2, h3; constexpr int b_ = VB * SHM_V + v_rd_off(d0, 0, 0);     \
        TRRD(l0, b_); TRRD(h0, b_ + 2048); TRRD(l1, b_ + 4096); TRRD(h1, b_ + 6144); TRRD(l2, b_ + 8192); TRRD(h2, b_ + 10240); TRRD(l3, b_ + 12288); TRRD(h3, b_ + 14336); \
        asm volatile("s_waitcnt lgkmcnt(0)" ::: "memory"); SBAR();                 \
        o[d0] = __builtin_amdgcn_mfma_f32_32x32x16_bf16(pa0, (bf16x8){l0[0], l0[1], l0[2], l0[3], h0[0], h0[1], h0[2], h0[3]}, o[d0], 0, 0, 0);   \
        o[d0] = __builtin_amdgcn_mfma_f32_32x32x16_bf16(pa1, (bf16x8){l1[0], l1[1], l1[2], l1[3], h1[0], h1[1], h1[2], h1[3]}, o[d0], 0, 0, 0);   \
        o[d0] = __builtin_amdgcn_mfma_f32_32x32x16_bf16(pa2, (bf16x8){l2[0], l2[1], l2[2], l2[3], h2[0], h2[1], h2[2], h2[3]}, o[d0], 0, 0, 0);   \
        o[d0] = __builtin_amdgcn_mfma_f32_32x32x16_bf16(pa3, (bf16x8){l3[0], l3[1], l3[2], l3[3], h3[0], h3[1], h3[2], h3[3]}, o[d0], 0, 0, 0); } while (0)
    PV_D0(0); PV_D0(1); PV_D0(2); PV_D0(3);
#undef PV_D0
#undef TRRD
}

template <class TIn, class TOut> struct BlockRef { const TIn* Q; const TIn* K; const TIn* V; TOut* O; const unsigned* sel; int P0; int W; };
template <class TIn> struct Seam {
    bf16x8 qr[8];
    bf16x8 st_v0, st_v1, st_k0, st_k1; f32x4 sf0, sf1, sf2, sf3;
    f32x4 tq[16];
};
__device__ __forceinline__ int swa_jlo(int P0, int W) { const int lowk = P0 - W + 1; return lowk > 0 ? lowk / KVBLK : 0; }
#define ROW(p, k0, rr) ((p) + (size_t)((k0) + (rr)) * LDK + sc)
#define VMW() asm volatile("s_waitcnt vmcnt(0)" ::: "memory")
#define VMWN(n) asm volatile("s_waitcnt vmcnt(%0)" :: "i"(n) : "memory")
#define SLOAD_H(Kp, Vp, k0) do { S.st_v0 = load8<TIn>(ROW(Vp, k0, sr)); S.st_v1 = load8<TIn>(ROW(Vp, k0, 32 + sr));              \
                         S.st_k0 = load8<TIn>(ROW(Kp, k0, sr)); S.st_k1 = load8<TIn>(ROW(Kp, k0, 32 + sr)); } while (0)
#define SWRITE_HK(bf) do { *(bf16x8*)(K_lds + (bf) * SHM_K + kws) = S.st_k0; *(bf16x8*)(K_lds + (bf) * SHM_K + kws + 32 * 256) = S.st_k1; } while (0)
#define SWRITE_HV(bf) do { *(bf16x8*)(V_lds + (bf) * SHM_V + vst0) = S.st_v0; *(bf16x8*)(V_lds + (bf) * SHM_V + vst1) = S.st_v1; } while (0)
#define SWRITE_H(bf) do { SWRITE_HV(bf); SWRITE_HK(bf); } while (0)
#define SLOAD_F(p, k0) do { S.sf0 = *(const f32x4*)ROW(p, k0, sr); S.sf1 = *(const f32x4*)(ROW(p, k0, sr) + 4);                \
                            S.sf2 = *(const f32x4*)ROW(p, k0, 32 + sr); S.sf3 = *(const f32x4*)(ROW(p, k0, 32 + sr) + 4); } while (0)
#define SWRITE_KF(bf) do { *(bf16x8*)(K_lds + (bf) * SHM_K + kws) = pack8(S.sf0, S.sf1); *(bf16x8*)(K_lds + (bf) * SHM_K + kws + 32 * 256) = pack8(S.sf2, S.sf3); } while (0)
#define SWRITE_VF(bf) do { *(bf16x8*)(V_lds + (bf) * SHM_V + vst0) = pack8(S.sf0, S.sf1); *(bf16x8*)(V_lds + (bf) * SHM_V + vst1) = pack8(S.sf2, S.sf3); } while (0)
template <class TIn, class TOut>
__device__ __forceinline__ void causal_swa_prime(const BlockRef<TIn, TOut>& cur, char* lds, Seam<TIn>& S) {
    constexpr bool F32 = same_t<TIn, float>::v;
    const int tid = opaque_tid(), wid = __builtin_amdgcn_readfirstlane(tid >> 6), lane = tid & 63, r32 = lane & 31, hi = lane >> 5;
    const int sr = tid >> 4, sc = (tid & 15) * 8, kws = KSWZ(sr, sc * 2); char* K_lds = lds + 2 * SHM_V;
    const int kb0 = swa_jlo(cur.P0, cur.W) * KVBLK;
    for (int d0 = 0; d0 < 8; ++d0) S.qr[d0] = load8<TIn>(cur.Q + (size_t)(wid * QBLK + r32) * LDQ + d0 * 16 + hi * 8);
    if constexpr (F32) { SLOAD_F((const float*)cur.K, kb0); VMW(); SWRITE_KF(0); SBAR(); SLOAD_F((const float*)cur.V, kb0); }
    else { SLOAD_H(cur.K, cur.V, kb0); VMW(); SWRITE_HK(0); }
    __syncthreads();
}
template <class TIn, class TOut>
__device__ __forceinline__ void causal_swa_block(const BlockRef<TIn, TOut>& cur, const BlockRef<TIn, TOut>& nxt, int skv, char* lds, Seam<TIn>& S) {
    constexpr bool F32 = same_t<TIn, float>::v;
    const int tid = opaque_tid(), wid = __builtin_amdgcn_readfirstlane(tid >> 6), lane = tid & 63, r32 = lane & 31, hi = lane >> 5;
    const int W = cur.W;
    const int j_lo = swa_jlo(cur.P0, W);
    const unsigned selw = cur.sel ? cur.sel[wid * QBLK + r32] : 0xffffffffu;
    int j_hi = (cur.P0 + QB - 1) / KVBLK + 1; if (j_hi > skv / KVBLK) j_hi = skv / KVBLK;
    const int NT = j_hi - j_lo;
    const int kbn = swa_jlo(nxt.P0, nxt.W) * KVBLK;
    const int qlo = cur.P0 + wid * QBLK, qm = qlo + r32 - 4 * hi;
    char* V_lds = lds; char* K_lds = lds + 2 * SHM_V;
    float* ws = (float*)(lds + 2 * SHM_V + 2 * SHM_K) + wid * 64; float* li_l = ws, * al_l = ws + 32;
    float m_reg = -1e30f, l_reg = 0; f32x16 o[4] = {};
    const int sr = tid >> 4, sc = (tid & 15) * 8, vst0 = v_st(sr, sc), vst1 = v_st(32 + sr, sc), kws = KSWZ(sr, sc * 2);
    const int vb0 = (int)(uintptr_t)V_lds + v_rd_base(lane);
    const TIn* Kh = cur.K; const TIn* Vh = cur.V;
#define RESC(a) do { if (__any((a) < 1.f)) { if (hi == 0) al_l[r32] = (a); asm volatile("s_waitcnt lgkmcnt(0)" ::: "memory");              \
                     for (int d_ = 0; d_ < 4; ++d_) for (int r = 0; r < 16; ++r) o[d_][r] *= al_l[crow(r, hi)]; } } while (0)
#define KBASE(t) ((j_lo + (t)) * KVBLK)
#define ACT(t) (KBASE(t) <= qlo + QBLK - 1 && KBASE(t) + KVBLK - 1 >= qlo - W + 1)
#define MASKT(P0_, P1_, t) do { const int kb_ = KBASE(t); if ((!SK || ACT(t)) && (kb_ + KVBLK - 1 > qlo || kb_ <= qlo + QBLK - 1 - W)) mask_tile(P0_, P1_, qm - kb_, (unsigned)W); \
        if (cur.sel) { if (!((selw >> (j_lo + (t))) & 1u)) { const float NEG_ = -__builtin_inff(); _Pragma("unroll") for (int r_ = 0; r_ < 16; ++r_) { P0_[r_] = NEG_; P1_[r_] = NEG_; } } } } while (0)
    constexpr int NQL = F32 ? 16 : 8;
    constexpr bool SK = WSKIP && !F32;
#define SEAM_K0() do { VMWN(NQL); if constexpr (F32) { SWRITE_KF(0); SBAR(); SLOAD_F((const float*)nxt.V, kbn); } else { SWRITE_HK(0); } SBAR(); } while (0)
    f32x16 pA0, pA1, pB0, pB1; float mnA, mnB, alA, alB; bf16x8 pa0, pa1, pa2, pa3;
    if constexpr (F32) { VMW(); SWRITE_VF(0); SBAR(); } else { SWRITE_HV(0); SBAR(); }
    if (NT > 1) { if constexpr (F32) SLOAD_F((const float*)Kh, KBASE(1)); else SLOAD_H(Kh, Vh, KBASE(1)); }
    SBAR(); qkt<0, SK>(pA0, pA1, K_lds, r32, hi, S.qr, ACT(0));
    if constexpr (F32) { if (NT > 1) { VMW(); SWRITE_KF(1); SBAR(); SLOAD_F((const float*)Vh, KBASE(1)); } }
    MASKT(pA0, pA1, 0); partialSM(pA0, pA1, m_reg, mnA, alA);
    if (NT > 1) { VMW(); if constexpr (F32) { SWRITE_VF(1); SBAR(); if (NT > 2) SLOAD_F((const float*)Kh, KBASE(2)); } else SWRITE_H(1); }
    __syncthreads();
#define HALF_STEP(PX0, PX1, mnX, alX, PY0, PY1, alY, t, KB, VB, SB) do {                                                      \
        SBAR(); qkt<KB, SK>(PX0, PX1, K_lds, r32, hi, S.qr, ACT(t));                                             \
        finishSM(PY0, PY1, alY, l_reg, pa0, pa1, pa2, pa3); SBAR();                                                           \
        if ((t) + 1 < NT) { if constexpr (F32) { VMW(); SWRITE_KF(SB); SBAR(); SLOAD_F((const float*)Vh, KBASE((t) + 1)); }  \
                            else { SLOAD_H(Kh, Vh, KBASE((t) + 1)); } SBAR(); }                                               \
        pv_tile<VB, SK>(o, vb0, pa0, pa1, pa2, pa3, ACT((t) - 1)); MASKT(PX0, PX1, (t)); partialSM(PX0, PX1, m_reg, mnX, alX);                                        \
        __syncthreads();                                                                                                      \
        if ((t) + 1 < NT) { VMW(); if constexpr (F32) { SWRITE_VF(SB); SBAR(); if ((t) + 2 < NT) SLOAD_F((const float*)Kh, KBASE((t) + 2)); } \
                            else { SWRITE_H(SB); } }                                                                          \
        RESC(alX); __syncthreads(); } while (0)
    for (int t = 1; t + 1 < NT; t += 2) {
        HALF_STEP(pB0, pB1, mnB, alB, pA0, pA1, alA, t, 1, 0, 0);
        HALF_STEP(pA0, pA1, mnA, alA, pB0, pB1, alB, t + 1, 0, 1, 1);
    }
    const bool even = (NT & 1) == 0;
    if (even) { SBAR(); qkt<1, SK>(pB0, pB1, K_lds, r32, hi, S.qr, ACT(NT - 1)); SBAR(); }
#define QROW(e) (nxt.Q + (size_t)(wid * QBLK + r32) * LDQ + ((e) >> 1) * 16 + hi * 8 + ((e) & 1) * 4)
    if constexpr (F32) { SLOAD_F((const float*)nxt.K, kbn); SBAR();
#pragma unroll
        for (int e = 0; e < 8; ++e) S.tq[e] = *(const f32x4*)QROW(e); }
    else { SLOAD_H(nxt.K, nxt.V, kbn); SBAR();
#pragma unroll
        for (int d0 = 0; d0 < 8; ++d0) S.qr[d0] = load8<TIn>(nxt.Q + (size_t)(wid * QBLK + r32) * LDQ + d0 * 16 + hi * 8); }
    SBAR();
    finishSM(pA0, pA1, alA, l_reg, pa0, pa1, pa2, pa3); SBAR();
    if constexpr (F32) {
#pragma unroll
        for (int e = 8; e < 16; ++e) S.tq[e] = *(const f32x4*)QROW(e); SBAR(); }
#undef QROW
    pv_tile<0, SK>(o, vb0, pa0, pa1, pa2, pa3, ACT(even ? NT - 2 : NT - 1));
    if (even) { MASKT(pB0, pB1, NT - 1); partialSM(pB0, pB1, m_reg, mnB, alB); __syncthreads(); RESC(alB);
        finishSM(pB0, pB1, alB, l_reg, pa0, pa1, pa2, pa3); SBAR(); pv_tile<1, SK>(o, vb0, pa0, pa1, pa2, pa3, ACT(NT - 1)); }
    SBAR(); SEAM_K0();
    if (hi == 0) li_l[r32] = l_reg; asm volatile("s_waitcnt lgkmcnt(0)" ::: "memory");
    float rli[16];
#pragma unroll
    for (int r = 0; r < 16; ++r) rli[r] = __builtin_amdgcn_rcpf(li_l[crow(r, hi)]);
    TOut* Ow = cur.O + (size_t)(wid * QBLK) * LDO;
#pragma unroll
    for (int r = 0; r < 16; ++r) { const int orow = crow(r, hi);
#pragma unroll
        for (int d0 = 0; d0 < 4; ++d0) { const float v = o[d0][r] * rli[r];
            if constexpr (same_t<TOut, float>::v) { Ow[(size_t)orow * LDO + d0 * 32 + r32] = v; }
            else { const float vn = __shfl_xor(v, 1);
                   if ((r32 & 1) == 0) *(unsigned*)(Ow + (size_t)orow * LDO + d0 * 32 + r32) = cvtpk(v, vn); } } }
    if constexpr (F32) {
#pragma unroll
        for (int d0 = 0; d0 < 8; ++d0) S.qr[d0] = pack8(S.tq[2 * d0], S.tq[2 * d0 + 1]); }
    __syncthreads();
#undef RESC
#undef KBASE
#undef ACT
#undef MASKT
#undef SEAM_K0
#undef HALF_STEP
}
#undef ROW
#undef VMW
#undef VMWN
#undef SLOAD_H
#undef SWRITE_HK
#undef SWRITE_HV
#undef SWRITE_H
#undef SLOAD_F
#undef SWRITE_KF
#undef SWRITE_VF

}
typedef unsigned short bf16_t;
typedef short bf16x8 __attribute__((ext_vector_type(8)));
typedef float f32x4 __attribute__((ext_vector_type(4)));
typedef float f32x16 __attribute__((ext_vector_type(16)));
typedef unsigned u32x4 __attribute__((ext_vector_type(4)));
typedef unsigned u32x2 __attribute__((ext_vector_type(2)));
constexpr size_t SZ_WA = (size_t)11264 * 2048 * 2, SZ_WD = (size_t)2048 * 5632 * 2, SZ_WIN = (size_t)NPROJ * 2048 * 2, SZ_WOUT = (size_t)2048 * 2048 * 2,
                 SZ_WC1 = (size_t)512 * 4096 * 2, SZ_WC2 = (size_t)256 * 512 * 2;
constexpr size_t OFF_W1A = 0, OFF_W1D = OFF_W1A + SZ_WA, OFF_W2A = OFF_W1D + SZ_WD, OFF_W2D = OFF_W2A + SZ_WA, OFF_WIN = OFF_W2D + SZ_WD, OFF_WOUT = OFF_WIN + SZ_WIN,
                 OFF_WC1 = OFF_WOUT + SZ_WOUT, OFF_WC2 = OFF_WC1 + SZ_WC1, SZ_LAYER = OFF_WC2 + SZ_WC2;
constexpr size_t SZ_O = (size_t)M_TOK * 1024 * 2;
constexpr size_t WS_HB = 2 * SZ_LAYER, WS_ACT = WS_HB + (size_t)M_TOK * DM * 2, WS_GATES = WS_ACT + (size_t)M_TOK * DFF * 2, WS_OCMP = WS_GATES + (size_t)M_TOK * 32 * 4,
                 WS_OSLC = WS_OCMP + SZ_O, WS_OWIN = WS_OSLC + SZ_O, WS_OD1 = WS_OWIN + SZ_O, WS_OD2 = WS_OD1 + SZ_O, WS_AKV = WS_OD1  ,
                 WS_HC = WS_OD2 + SZ_O, WS_KC = WS_HC + (size_t)2048 * 512 * 2, WS_VCT = WS_KC + (size_t)16 * 128 * 128 * 2, WS_SELM = WS_VCT + (size_t)16 * 128 * 128 * 2,
                 WS_ROPEC = WS_SELM + (size_t)16 * 2048 * 4, WS_ROPES = WS_ROPEC + (size_t)2048 * 64 * 4, WS_END = WS_ROPES + (size_t)2048 * 64 * 4;
static_assert(SZ_LAYER % 256 == 0 && (size_t)4096 * 4096 * 2 == SZ_O, "layout");

struct Params { const float* in[24]; float* out; unsigned char* ws; };
typedef const __attribute__((address_space(4))) Params* KParamsPtr;

__device__ __forceinline__ unsigned cvtpk2(float lo, float hi) { unsigned r; asm volatile("v_cvt_pk_bf16_f32 %0, %1, %2" : "=v"(r) : "v"(lo), "v"(hi)); return r; }
__device__ __forceinline__ float bf_lo(unsigned w) { return __uint_as_float(w << 16); }
__device__ __forceinline__ float bf_hi(unsigned w) { return __uint_as_float(w & 0xffff0000u); }

__device__ __forceinline__ void tc_tile(const float* __restrict__ src, int ld_src, int col0, int ncv, int ks0, bf16_t* __restrict__ dst, int ld_dst, int row0, int kd0, float* tile) {
    const int tid = opaque_tid(), cc = tid & 63, kb = tid >> 6;
#pragma unroll
    for (int i = 0; i < 8; ++i) { const int kk = kb + 8 * i; float v = 0.f; if (ks0 >= 0 && cc < ncv) v = src[(size_t)(ks0 + kk) * ld_src + col0 + cc]; tile[kk * 65 + cc] = v; }
    __syncthreads();
    const int rr = tid >> 3, kq = (tid & 7) * 8;
    u32x4 w;
    w.x = cvtpk2(tile[(kq + 0) * 65 + rr], tile[(kq + 1) * 65 + rr]); w.y = cvtpk2(tile[(kq + 2) * 65 + rr], tile[(kq + 3) * 65 + rr]);
    w.z = cvtpk2(tile[(kq + 4) * 65 + rr], tile[(kq + 5) * 65 + rr]); w.w = cvtpk2(tile[(kq + 6) * 65 + rr], tile[(kq + 7) * 65 + rr]);
    *(u32x4*)(dst + (size_t)(row0 + rr) * ld_dst + kd0 + kq) = w;
    __syncthreads();
}
__device__ void prep_phase(KParamsPtr pp_, float* tile) {
    const int G = gridDim.x, bx = blockIdx.x;
    for (int l = 0; l < 2; ++l) {
        unsigned char* wl = pp_->ws + (size_t)l * SZ_LAYER;
        for (int f = 0; f < 2; ++f) {
            const float* gate = pp_->in[f ? 20 : 2] + (size_t)l * DM * DFF; const float* up = pp_->in[f ? 21 : 3] + (size_t)l * DM * DFF; const float* down = pp_->in[f ? 22 : 4] + (size_t)l * DM * DFF;
            bf16_t* dA = (bf16_t*)(wl + (f ? OFF_W2A : OFF_W1A)); bf16_t* dD = (bf16_t*)(wl + (f ? OFF_W2D : OFF_W1D));
            for (int tix = bx; tix < 176 * 32; tix += G) { const int rg = tix >> 5, kg = tix & 31, pp = rg >> 2, q = rg & 3;
                tc_tile(q < 2 ? gate : up, DFF, 128 * pp + 64 * (q & 1), 64, kg * 64, dA, DM, rg * 64, kg * 64, tile); }
            for (int tix = bx; tix < 32 * 88; tix += G) { const int rg = tix / 88, kg = tix - rg * 88;
                tc_tile(down, DM, 64 * rg, 64, kg * 64, dD, DFF, rg * 64, kg * 64, tile); }
        }
        { const float* w = pp_->in[6] + (size_t)l * DM * 5656; bf16_t* dst = (bf16_t*)(wl + OFF_WIN);
          for (int tix = bx; tix < 92 * 32; tix += G) { const int rg = tix >> 5, kg = tix & 31, pn = rg >> 2, q = rg & 3; int col0 = 0, ncv = 64, ks0 = kg * 64;
              if (pn == 22) { if (q == 0) { col0 = 2560; ncv = 24; } else ks0 = -1; }
              else { const int pcol = is_rope_tile(pn) ? 256 * pn + (q & 1) * 128 + 64 * (q >> 1) : 256 * pn + 64 * q; col0 = pcol < 2560 ? pcol : pcol + 24; }
              tc_tile(w, 5656, col0, ncv, ks0, dst, DM, rg * 64, kg * 64, tile); } }
        { const float* w = pp_->in[18] + (size_t)l * DM * DM; bf16_t* dst = (bf16_t*)(wl + OFF_WOUT);
          for (int tix = bx; tix < 32 * 32; tix += G) { const int rg = tix >> 5, kg = tix & 31; tc_tile(w, DM, 64 * rg, 64, kg * 64, dst, DM, rg * 64, kg * 64, tile); } }
        { const float* wk = pp_->in[9] + (size_t)l * 4096 * 256; const float* wv = pp_->in[11] + (size_t)l * 4096 * 256; bf16_t* dst = (bf16_t*)(wl + OFF_WC1);
          for (int tix = bx; tix < 8 * 64; tix += G) { const int rg = tix >> 6, kg = tix & 63; tc_tile(rg < 4 ? wk : wv, 256, 64 * (rg & 3), 64, kg * 64, dst, 4096, rg * 64, kg * 64, tile); } }
        { const float* wk = pp_->in[10] + (size_t)l * 256 * 128; const float* wv = pp_->in[12] + (size_t)l * 256 * 128; bf16_t* dst = (bf16_t*)(wl + OFF_WC2);
          for (int tix = bx; tix < 4 * 8; tix += G) { const int rg = tix >> 3, kg = tix & 7; const int ks0 = rg < 2 ? (kg < 4 ? kg * 64 : -1) : (kg >= 4 ? (kg - 4) * 64 : -1);
              tc_tile(rg < 2 ? wk : wv, 128, 64 * (rg & 1), 64, ks0, dst, 512, rg * 64, kg * 64, tile); } }
    }
    float* rc = (float*)(pp_->ws + WS_ROPEC); float* rs = (float*)(pp_->ws + WS_ROPES);
    for (int i = bx * 512 + opaque_tid(); i < TSEQ * 64; i += G * 512) { const int t = i >> 6, d = i & 63;
        const float inv = __builtin_amdgcn_exp2f(-(float)d * 0.20762050593046014f);
        const float ang = (float)t * inv; float rev = ang * 0.15915494309189535f; rev -= floorf(rev);
        rc[i] = __builtin_amdgcn_cosf(rev); rs[i] = __builtin_amdgcn_sinf(rev); }
}

template <bool TO_BF16>
__device__ void rmsnorm_phase(const float* __restrict__ x, const float* __restrict__ g, bf16_t* __restrict__ ob, float* of) {
    const int tid_ = opaque_tid(); const int wid = tid_ >> 6, lane = tid_ & 63;
    f32x4 gv[8];
#pragma unroll
    for (int i = 0; i < 8; ++i) gv[i] = *(const f32x4*)(g + (lane + 64 * i) * 4);
    for (int row = blockIdx.x * 8 + wid; row < M_TOK; row += gridDim.x * 8) {
        const float* xr = x + (size_t)row * DM; f32x4 v[8]; float ss = 0.f;
#pragma unroll
        for (int i = 0; i < 8; ++i) { v[i] = *(const f32x4*)(xr + (lane + 64 * i) * 4); ss += v[i][0] * v[i][0] + v[i][1] * v[i][1] + v[i][2] * v[i][2] + v[i][3] * v[i][3]; }
#pragma unroll
        for (int o = 32; o >= 1; o >>= 1) ss += __shfl_xor(ss, o);
        const float rstd = 1.0f / sqrtf(ss * (1.0f / DM) + 1e-6f);
#pragma unroll
        for (int i = 0; i < 8; ++i) { const f32x4 y = v[i] * rstd * gv[i];
            if (TO_BF16) { u32x2 w; w.x = cvtpk2(y[0], y[1]); w.y = cvtpk2(y[2], y[3]); *(u32x2*)(ob + (size_t)row * DM + (lane + 64 * i) * 4) = w; }
            else *(f32x4*)(of + (size_t)row * DM + (lane + 64 * i) * 4) = y; }
    }
}

__device__ void im2col_phase(const bf16_t* __restrict__ P, const float* __restrict__ posk, const float* __restrict__ posv, bf16_t* __restrict__ AKV) {
    const int nth = gridDim.x * 512;
    for (int i = blockIdx.x * 512 + opaque_tid(); i < 2 * 16 * 128 * 32 * 16; i += nth) {
        const int c8 = i & 15, l = (i >> 4) & 31, n = (i >> 9) & 127, bg = (i >> 16) & 15, kv = i >> 20, b = bg >> 1, g = bg & 1;
        u32x4 w = {0u, 0u, 0u, 0u};
        if (n < 127) {
            const u32x4 s = *(const u32x4*)(P + (size_t)(b * TSEQ + 16 * n + l) * LDP + (kv ? 1280 : 1024) + g * 128 + c8 * 8);
            const float* pp = (kv ? posv : posk) + l * 128 + c8 * 8; const f32x4 p0 = *(const f32x4*)pp, p1 = *(const f32x4*)(pp + 4);
            w.x = cvtpk2(bf_lo(s.x) + p0[0], bf_hi(s.x) + p0[1]); w.y = cvtpk2(bf_lo(s.y) + p0[2], bf_hi(s.y) + p0[3]);
            w.z = cvtpk2(bf_lo(s.z) + p1[0], bf_hi(s.z) + p1[1]); w.w = cvtpk2(bf_lo(s.w) + p1[2], bf_hi(s.w) + p1[3]);
        }
        *(u32x4*)(AKV + (size_t)(kv * 2048 + bg * 128 + n) * 4096 + l * 128 + c8 * 8) = w;
    }
}

__device__ __forceinline__ int crow16(int r, int hi) { return (r & 3) + 8 * (r >> 2) + 4 * hi; }
__device__ void cmp_attn_phase(const bf16_t* __restrict__ P, const bf16_t* __restrict__ KC, const bf16_t* __restrict__ VCT, bf16_t* __restrict__ OCMP, unsigned* __restrict__ SELM, float* limp_all) {
    const int tid = opaque_tid(), wid = tid >> 6, lane = tid & 63, c = lane & 31, hi = lane >> 5;
    float* limp = limp_all + wid * 256;
    constexpr float C2 = 1.4426950408889634f * 0.08838834764831845f;
    const float NEGINF = -__builtin_inff();
    for (int item = blockIdx.x * 8 + wid; item < 4096; item += gridDim.x * 8) {
        const int bg = item >> 8, tg = item & 255, b = bg >> 1, g = bg & 1, t0 = tg * 8;
        const int tok = c & 7, hr = c >> 3, t = t0 + tok;
        const bf16_t* qp = P + (size_t)(b * TSEQ + t) * LDP + (g * 4 + hr) * 128 + hi * 8;
        bf16x8 qf[8];
#pragma unroll
        for (int ks = 0; ks < 8; ++ks) qf[ks] = *(const bf16x8*)(qp + ks * 16);
        const int nkg = (t0 + 7 >= 31) ? (((t0 + 7 - 31) >> 4) >> 5) + 1 : 0;
        const int nv = (t >= 31) ? ((t - 31) >> 4) : -1;
        const bf16_t* kcb = KC + (size_t)bg * 128 * 128; const bf16_t* vcb = VCT + (size_t)bg * 128 * 128;
        f32x16 s[4];
#pragma unroll
        for (int kg = 0; kg < 4; ++kg) { s[kg] = f32x16{};
            if (kg < nkg) {
#pragma unroll
                for (int ks = 0; ks < 8; ++ks) { const bf16x8 kf = *(const bf16x8*)(kcb + (size_t)(kg * 32 + c) * 128 + ks * 16 + hi * 8); s[kg] = __builtin_amdgcn_mfma_f32_32x32x16_bf16(kf, qf[ks], s[kg], 0, 0, 0); } } }
        float mx = NEGINF;
#pragma unroll
        for (int kg = 0; kg < 4; ++kg)
#pragma unroll
            for (int r = 0; r < 16; ++r) { const int n = kg * 32 + crow16(r, hi); const float x = (n <= nv) ? s[kg][r] * C2 : NEGINF; s[kg][r] = x; mx = fmaxf(mx, x); }
        mx = fmaxf(mx, __shfl_xor(mx, 32));
        if (mx == NEGINF) mx = 0.f;
        float sum = 0.f;
#pragma unroll
        for (int kg = 0; kg < 4; ++kg)
#pragma unroll
            for (int r = 0; r < 16; ++r) { const float e = __builtin_amdgcn_exp2f(s[kg][r] - mx); s[kg][r] = e; sum += e; }
        sum += __shfl_xor(sum, 32);
        const float inv = sum > 0.f ? 1.0f / sum : 0.f;
#pragma unroll
        for (int kg = 0; kg < 4; ++kg)
#pragma unroll
            for (int r = 0; r < 16; ++r) s[kg][r] *= inv;
        float av[16], rv[16];
#pragma unroll
        for (int f = 0; f < 16; ++f) { const int kg = f >> 2, q4 = (f & 3) * 4; const float bb = 0.5f * s[kg][q4 + 3]; av[f] = s[kg][q4] + s[kg][q4 + 1] + s[kg][q4 + 2] + bb; rv[f] = __shfl_xor(bb, 32); }
#pragma unroll
        for (int f = 0; f < 16; ++f) { float im = av[f] + (hi ? rv[f] : (f > 0 ? rv[f > 0 ? f - 1 : 0] : 0.f));
            im += __shfl_xor(im, 8); im += __shfl_xor(im, 16);
            if (c < 8) limp[tok * 32 + 2 * f + hi] = im; }
        bf16x8 pa[8];
#define CMP_PK4(PV, B_, OUT) do { unsigned a0 = cvtpk2(PV[B_ + 0], PV[B_ + 1]), a1 = cvtpk2(PV[B_ + 2], PV[B_ + 3]), b0 = cvtpk2(PV[B_ + 4], PV[B_ + 5]), b1 = cvtpk2(PV[B_ + 6], PV[B_ + 7]); \
        auto r0 = __builtin_amdgcn_permlane32_swap(a0, b0, false, false); auto r1 = __builtin_amdgcn_permlane32_swap(a1, b1, false, false); \
        u32x4 w_ = {r0[0], r1[0], r0[1], r1[1]}; OUT = *reinterpret_cast<bf16x8*>(&w_); } while (0)
#pragma unroll
        for (int kg = 0; kg < 4; ++kg) { CMP_PK4(s[kg], 0, pa[2 * kg]); CMP_PK4(s[kg], 8, pa[2 * kg + 1]); }
#undef CMP_PK4
        bf16_t* ob = OCMP + (size_t)(b * TSEQ + t0) * 1024 + g * 512;
#pragma unroll
        for (int d0 = 0; d0 < 4; ++d0) { f32x16 o = f32x16{};
#pragma unroll
            for (int u = 0; u < 8; ++u) if (u < 2 * nkg) { const bf16x8 vf = *(const bf16x8*)(vcb + (size_t)(d0 * 32 + c) * 128 + u * 16 + hi * 8); o = __builtin_amdgcn_mfma_f32_32x32x16_bf16(pa[u], vf, o, 0, 0, 0); }
#pragma unroll
            for (int r = 0; r < 16; ++r) { const int qrow = crow16(r, hi); const float v = o[r], vn = __shfl_xor(v, 1);
                if ((c & 1) == 0) *(unsigned*)(ob + (size_t)(qrow & 7) * 1024 + (qrow >> 3) * 128 + d0 * 32 + c) = cvtpk2(v, vn); } }
        asm volatile("s_waitcnt lgkmcnt(0)" ::: "memory");
        const int tk = lane & 7, tt = t0 + tk, cur = tt >> 6;
        unsigned mask;
        if (t0 < 1024) mask = (2u << cur) - 1u;
        else {
            float v[32];
#pragma unroll
            for (int sI = 0; sI < 32; ++sI) { float x = limp[tk * 32 + sI]; const bool forced = (sI == 0) | (sI == cur) | (sI == cur - 1); x = forced ? 1e4f : x; v[sI] = (sI <= cur) ? x : -1.f; }
            mask = 0u;
#pragma unroll
            for (int sI = 0; sI < 32; ++sI) { int rank = 0;
#pragma unroll
                for (int s2 = 0; s2 < 32; ++s2) { if (s2 < sI) rank += (v[s2] >= v[sI]) ? 1 : 0; else if (s2 > sI) rank += (v[s2] > v[sI]) ? 1 : 0; }
                if (rank < 16 && v[sI] >= 0.f) mask |= 1u << sI; }
        }
        if (lane < 8) SELM[bg * TSEQ + tt] = mask;
        asm volatile("s_waitcnt lgkmcnt(0)" ::: "memory");
    }
}

typedef att::BlockRef<att::bf16, att::bf16> ABlk;
__device__ __forceinline__ ABlk attn_decode(int i, const bf16_t* P, bf16_t* OSLC, bf16_t* OWIN, bf16_t* OD1, bf16_t* OD2, const unsigned* SELM) {
    int kind, j, qb;
    if (i < 960) { qb = 7 - i / 192; j = i % 192; kind = 0; }
    else if (i < 1536) { j = i - 960; if (j < 192) { kind = 0; qb = 2; } else { kind = 1; j -= 192; qb = 2 + (j >> 6); j &= 63; } }
    else if (i < 1792) { j = i - 1536; qb = 1; if (j < 192) kind = 0; else { kind = 1; j -= 192; } }
    else { j = i - 1792; qb = 0; if (j < 192) kind = 0; else { kind = 1; j -= 192; } }
    int b, qcol, kcol, vcol, ocol; bf16_t* O; const unsigned* sel = nullptr; int W = 1 << 20;
    if (kind == 1) { b = j >> 3; const int h = j & 7; qcol = h * 128; kcol = 2048 + (h >> 2) * 128; vcol = 2304 + (h >> 2) * 128; O = OWIN; ocol = h * 128; W = 512; }
    else if (j >= 128) { j -= 128; b = j >> 3; const int h = j & 7; qcol = h * 128; kcol = 1536 + (h >> 2) * 128; vcol = 1792 + (h >> 2) * 128; O = OSLC; ocol = h * 128;
        sel = SELM + (size_t)(b * 2 + (h >> 2)) * TSEQ + qb * 256; }
    else { b = j >> 4; const int hd = (j >> 2) & 3, cc = (j >> 1) & 1, vh = j & 1; qcol = 2560 + (hd * 2 + cc) * 128; kcol = 3584 + (hd * 2 + cc) * 128; vcol = 4608 + hd * 256 + vh * 128;
        O = cc ? OD2 : OD1; ocol = hd * 256 + vh * 128; }
    ABlk r;
    r.Q = (const att::bf16*)(P + (size_t)(b * TSEQ + qb * 256) * LDP + qcol); r.K = (const att::bf16*)(P + (size_t)(b * TSEQ) * LDP + kcol); r.V = (const att::bf16*)(P + (size_t)(b * TSEQ) * LDP + vcol);
    r.O = (att::bf16*)(O + (size_t)(b * TSEQ + qb * 256) * 1024 + ocol); r.sel = sel; r.P0 = qb * 256; r.W = W;
    return r;
}
__device__ void attn_phase(const bf16_t* P, bf16_t* OSLC, bf16_t* OWIN, bf16_t* OD1, bf16_t* OD2, const unsigned* SELM, char* lds) {
    const int G = gridDim.x, w = blockIdx.x;
    int rnd = 0; int si = w;
    if (si >= 2048) return;
    ABlk cur = attn_decode(si, P, OSLC, OWIN, OD1, OD2, SELM);
    att::Seam<att::bf16> S;
    att::causal_swa_prime<att::bf16, att::bf16>(cur, lds, S);
    for (;;) {
        const int rn = rnd + 1; const int sn = rn * G + ((rn & 1) ? G - 1 - w : w); const bool more = sn < 2048;
        const ABlk nxt = more ? attn_decode(sn, P, OSLC, OWIN, OD1, OD2, SELM) : cur;
        att::causal_swa_block<att::bf16, att::bf16>(cur, nxt, TSEQ, lds, S);
        if (!more) break;
        cur = nxt; rnd = rn;
    }
}

__device__ __forceinline__ void ld16bf(const bf16_t* p, float (&o)[16]) { const u32x4 a = *(const u32x4*)p, b = *(const u32x4*)(p + 8);
    o[0] = bf_lo(a.x); o[1] = bf_hi(a.x); o[2] = bf_lo(a.y); o[3] = bf_hi(a.y); o[4] = bf_lo(a.z); o[5] = bf_hi(a.z); o[6] = bf_lo(a.w); o[7] = bf_hi(a.w);
    o[8] = bf_lo(b.x); o[9] = bf_hi(b.x); o[10] = bf_lo(b.y); o[11] = bf_hi(b.y); o[12] = bf_lo(b.z); o[13] = bf_hi(b.z); o[14] = bf_lo(b.w); o[15] = bf_hi(b.w); }
__device__ __forceinline__ void st16bf(bf16_t* p, const float (&v)[16]) { u32x4 a, b; a.x = cvtpk2(v[0], v[1]); a.y = cvtpk2(v[2], v[3]); a.z = cvtpk2(v[4], v[5]); a.w = cvtpk2(v[6], v[7]);
    b.x = cvtpk2(v[8], v[9]); b.y = cvtpk2(v[10], v[11]); b.z = cvtpk2(v[12], v[13]); b.w = cvtpk2(v[14], v[15]); *(u32x4*)p = a; *(u32x4*)(p + 8) = b; }
__device__ void combine_phase(KParamsPtr pp_, int l, const float* __restrict__ gates, const bf16_t* OCMP, const bf16_t* OSLC, const bf16_t* OWIN, const bf16_t* OD1, const bf16_t* OD2, bf16_t* HB) {
    const int tid_ = opaque_tid(); const int wid = tid_ >> 6, lane = tid_ & 63;
    const float* q1 = pp_->in[13] + l * 128; const float* k1 = pp_->in[14] + l * 128; const float* q2 = pp_->in[15] + l * 128; const float* k2 = pp_->in[16] + l * 128;
    float s1 = q1[lane] * k1[lane] + q1[lane + 64] * k1[lane + 64], s2 = q2[lane] * k2[lane] + q2[lane + 64] * k2[lane + 64];
#pragma unroll
    for (int o = 32; o >= 1; o >>= 1) { s1 += __shfl_xor(s1, o); s2 += __shfl_xor(s2, o); }
    const float lam_init = l == 0 ? 0.2f : 0.35550906759096926f;
    const float lam = expf(s1) - expf(s2) + lam_init;
    float sg[16]; { const float* sp = pp_->in[17] + l * 256 + (lane & 15) * 16;
#pragma unroll
        for (int j = 0; j < 16; ++j) sg[j] = sp[j] * (1.0f - lam_init); }
    for (int row = blockIdx.x * 8 + wid; row < M_TOK; row += gridDim.x * 8) {
        { const int head = lane >> 3; const float* gp = gates + (size_t)row * 32 + head * 3; const float g0 = gp[0], g1 = gp[1], g2 = gp[2];
          float a[16], bq[16], cq[16]; const size_t off = (size_t)row * 1024 + lane * 16;
          ld16bf(OCMP + off, a); ld16bf(OSLC + off, bq); ld16bf(OWIN + off, cq);
#pragma unroll
          for (int j = 0; j < 16; ++j) a[j] = g0 * a[j] + g1 * bq[j] + g2 * cq[j];
          st16bf(HB + (size_t)row * DM + lane * 16, a); }
        { float a[16], bq[16]; const size_t off = (size_t)row * 1024 + lane * 16;
          ld16bf(OD1 + off, a); ld16bf(OD2 + off, bq); float ss = 0.f;
#pragma unroll
          for (int j = 0; j < 16; ++j) { a[j] = a[j] - lam * bq[j]; ss += a[j] * a[j]; }
          ss += __shfl_xor(ss, 1); ss += __shfl_xor(ss, 2); ss += __shfl_xor(ss, 4); ss += __shfl_xor(ss, 8);
          const float rstd = 1.0f / sqrtf(ss * (1.0f / 256.0f) + 1e-6f);
#pragma unroll
          for (int j = 0; j < 16; ++j) a[j] = a[j] * rstd * sg[j];
          st16bf(HB + (size_t)row * DM + 1024 + lane * 16, a); }
    }
}

constexpr int LDS_TOTAL = pg8::STAGE_BYTES;
__device__ __forceinline__ KParamsPtr kparams() { KParamsPtr q = (KParamsPtr)__builtin_amdgcn_kernarg_segment_ptr(); asm volatile("" : "+s"(q)); return q; }
#define WSP(T, off) ((T*)(pp->ws + (off)))
__global__ void __launch_bounds__(512) mega_fwd(Params p_unused) {
    extern __shared__ __attribute__((aligned(16))) unsigned char lds[];
    cg::grid_group grid = cg::this_grid();
    PG8_LAS unsigned char* glds = (PG8_LAS unsigned char*)lds;
    { KParamsPtr pp = kparams(); prep_phase(pp, (float*)lds); }
    grid.sync();
    for (int step = 0; step < 6; ++step) {
        const int l = step / 3, k = step - 3 * l;
        { KParamsPtr pp = kparams(); const float* xsrc = (step == 0) ? pp->in[0] : pp->out;
          const float* ng = (k == 0 ? pp->in[1] : (k == 1 ? pp->in[5] : pp->in[19])) + (size_t)l * DM;
          rmsnorm_phase<true>(xsrc, ng, WSP(bf16_t, WS_HB), nullptr); }
        grid.sync();
        if (k != 1) {
            { KParamsPtr pp = kparams(); const int G = gridDim.x, bx = blockIdx.x; unsigned char* wl = pp->ws + (size_t)l * SZ_LAYER;
              pg8::Gemm g{WSP(bf16_t, WS_HB), (const bf16_t*)(wl + (k == 0 ? OFF_W1A : OFF_W2A)), M_TOK, 2 * DFF, DM}; pg8::StaticOrder S; S.init(M_TOK, 2 * DFF, G, bx);
              pg8::EpiSwiGLU E{WSP(bf16_t, WS_ACT), DFF}; pg8::gemm_phase<pg8::EpiSwiGLU, pg8::StaticOrder>(glds, g, S, E, nullptr); }
            grid.sync();
        } else {
            { KParamsPtr pp = kparams(); const int G = gridDim.x, bx = blockIdx.x; unsigned char* wl = pp->ws + (size_t)l * SZ_LAYER;
              pg8::Gemm g{WSP(bf16_t, WS_HB), (const bf16_t*)(wl + OFF_WIN), M_TOK, NPROJ, DM}; pg8::StaticOrder S; S.init(M_TOK, NPROJ, G, bx);
              pg8::EpiProj E{WSP(bf16_t, WS_ACT), WSP(float, WS_GATES), WSP(const float, WS_ROPEC), WSP(const float, WS_ROPES)}; pg8::gemm_phase<pg8::EpiProj, pg8::StaticOrder>(glds, g, S, E, nullptr); }
            grid.sync();
            { KParamsPtr pp = kparams(); im2col_phase(WSP(const bf16_t, WS_ACT), pp->in[7] + (size_t)l * 4096, pp->in[8] + (size_t)l * 4096, WSP(bf16_t, WS_AKV)); }
            grid.sync();
            { KParamsPtr pp = kparams(); unsigned char* wl = pp->ws + (size_t)l * SZ_LAYER;
              pg8::Gemm g{WSP(bf16_t, WS_AKV), (const bf16_t*)(wl + OFF_WC1), 4096, 512, 4096}; pg8::DiagOrder S{(int)blockIdx.x};
              pg8::EpiSiluH E{WSP(bf16_t, WS_HC)}; pg8::gemm_phase<pg8::EpiSiluH, pg8::DiagOrder>(glds, g, S, E, nullptr); }
            grid.sync();
            { KParamsPtr pp = kparams(); unsigned char* wl = pp->ws + (size_t)l * SZ_LAYER;
              pg8::Gemm g{WSP(bf16_t, WS_HC), (const bf16_t*)(wl + OFF_WC2), 2048, 256, 512}; pg8::StaticOrder S; S.init(2048, 256, gridDim.x, blockIdx.x);
              pg8::EpiKCVC E{WSP(bf16_t, WS_KC), WSP(bf16_t, WS_VCT)}; pg8::gemm_phase<pg8::EpiKCVC, pg8::StaticOrder>(glds, g, S, E, nullptr); }
            grid.sync();
            { KParamsPtr pp = kparams(); cmp_attn_phase(WSP(const bf16_t, WS_ACT), WSP(const bf16_t, WS_KC), WSP(const bf16_t, WS_VCT), WSP(bf16_t, WS_OCMP), WSP(unsigned, WS_SELM), (float*)lds); }
            grid.sync();
            { KParamsPtr pp = kparams(); attn_phase(WSP(const bf16_t, WS_ACT), WSP(bf16_t, WS_OSLC), WSP(bf16_t, WS_OWIN), WSP(bf16_t, WS_OD1), WSP(bf16_t, WS_OD2), WSP(const unsigned, WS_SELM), (char*)lds); }
            grid.sync();
            { KParamsPtr pp = kparams(); combine_phase(pp, l, WSP(const float, WS_GATES), WSP(const bf16_t, WS_OCMP), WSP(const bf16_t, WS_OSLC), WSP(const bf16_t, WS_OWIN), WSP(const bf16_t, WS_OD1), WSP(const bf16_t, WS_OD2), WSP(bf16_t, WS_HB)); }
            grid.sync();
        }
        { KParamsPtr pp = kparams(); unsigned char* wl = pp->ws + (size_t)l * SZ_LAYER; const float* xsrc = (step == 0) ? pp->in[0] : pp->out;
          pg8::Gemm gr; float rscale;
          if (k != 1) { gr = pg8::Gemm{WSP(bf16_t, WS_ACT), (const bf16_t*)(wl + (k == 0 ? OFF_W1D : OFF_W2D)), M_TOK, DM, DFF}; rscale = 0.5f; }
          else { gr = pg8::Gemm{WSP(bf16_t, WS_HB), (const bf16_t*)(wl + OFF_WOUT), M_TOK, DM, DM}; rscale = 1.0f; }
          pg8::StaticOrder S; S.init(M_TOK, DM, gridDim.x, blockIdx.x); pg8::EpiRes E{xsrc, pp->out, DM, rscale}; pg8::gemm_phase<pg8::EpiRes, pg8::StaticOrder>(glds, gr, S, E, nullptr); }
        grid.sync();
    }
    { KParamsPtr pp = kparams(); rmsnorm_phase<false>(pp->out, pp->in[23], nullptr, pp->out); }
}

extern "C" void kernel_launch(void* const* d_in, const int* in_sizes, int n_in, void* d_out, int out_size, void* d_ws, size_t ws_size, hipStream_t stream) {
    static int grid = 0;
    if (grid == 0) {
        if (n_in != 24 || in_sizes[0] != M_TOK * DM || out_size != M_TOK * DM || ws_size < WS_END) {
            fprintf(stderr, "kernel_launch: unexpected shapes (n_in %d, in0 %d, out %d, ws %zu need %zu)\n", n_in, n_in > 0 ? in_sizes[0] : -1, out_size, ws_size, (size_t)WS_END); grid = -1; return; }
        int dev = 0, cus = 0, per_cu = 0;
        (void)hipGetDevice(&dev); (void)hipDeviceGetAttribute(&cus, hipDeviceAttributeMultiprocessorCount, dev);
        if (hipFuncSetAttribute((const void*)mega_fwd, hipFuncAttributeMaxDynamicSharedMemorySize, LDS_TOTAL) != hipSuccess) { fprintf(stderr, "kernel_launch: hipFuncSetAttribute failed\n"); grid = -1; return; }
        if (hipOccupancyMaxActiveBlocksPerMultiprocessor(&per_cu, (const void*)mega_fwd, 512, LDS_TOTAL) != hipSuccess || per_cu < 1) { fprintf(stderr, "kernel_launch: occupancy query gave %d\n", per_cu); per_cu = 1; }
        (void)hipGetLastError();
        if (cus <= 0) cus = 256;
        grid = cus;
    }
    if (grid < 0) return;
    Params p{};
    for (int i = 0; i < 24; ++i) p.in[i] = (const float*)d_in[i];
    p.out = (float*)d_out; p.ws = (unsigned char*)d_ws;
    void* args[] = {&p};
    hipError_t e = hipLaunchCooperativeKernel((const void*)mega_fwd, dim3(grid), dim3(512), args, LDS_TOTAL, stream);
    if (e != hipSuccess) fprintf(stderr, "kernel_launch: cooperative launch failed: %s (grid %d)\n", hipGetErrorString(e), grid);
}
```

```cpp
#include <hip/hip_runtime.h>
#include <hip/hip_bf16.h>
#include <hip/hip_cooperative_groups.h>
#include <cstdio>
#include <cstdint>
namespace cg = cooperative_groups;
#define PROBE_SYNC 0
#define PROBE_ATT 0
#define PROBE_PREP 0
#define PROBE_CMP 0
#define PROBE_NORM 0
#define PROBE_HOT 0
#define PROBE_EPI 0
#define PROBE_UP 0
#define PROBE_DOWN 0
__device__ __forceinline__ int opaque_bx() { int b = blockIdx.x; asm volatile("" : "+s"(b)); return b; }
__device__ __forceinline__ int opaque_gx() { int g = gridDim.x; asm volatile("" : "+s"(g)); return g; }
__device__ __forceinline__ int opaque_tid() { int t = threadIdx.x; asm volatile("" : "+v"(t)); return t; }

constexpr int M_TOK = 16384, DM = 2048, DFF = 5632, LDP = 5632, NPROJ = 5888, TSEQ = 2048;
__host__ __device__ constexpr bool is_rope_tile(int pn) { return pn <= 4 || pn == 6 || pn == 8 || (pn >= 10 && pn < 18); }

namespace pg8 {
#define PG8_LAS __attribute__((address_space(3)))
typedef unsigned short bf16_t;
typedef short bf16x8 __attribute__((ext_vector_type(8)));
typedef float f32x4 __attribute__((ext_vector_type(4)));
typedef unsigned u32x4 __attribute__((ext_vector_type(4)));
constexpr int BM = 256, BK = 64, HALF = 128, HTB = HALF * BK * 2  , STAGE_BYTES = 8 * HTB, NXCD = 8, WGM = 8;

__host__ __device__ __forceinline__ int lds_byte(int r, int c) { const int st = (r >> 4) * 2 + (c >> 5), rr = r & 15, cc = c & 31, ob = rr * 64 + cc * 2; return st * 1024 + (ob ^ (((ob >> 9) & 1) << 5)); }
__host__ __device__ __forceinline__ void stage_rc(int b, int& R, int& C) { const int st = b / 1024, sb = b % 1024, swz = sb ^ (((sb >> 9) & 1) << 5); R = (st >> 1) * 16 + swz / 64; C = (st & 1) * 32 + (swz % 64) / 2; }
__host__ __device__ __forceinline__ int perm32(int rho) { const int n = rho >> 4, i = rho & 15; return 8 * (i >> 2) + 4 * n + (i & 3); }

struct Unit { int pm, pn, ko = 0; };
struct Gemm { const bf16_t* A; const bf16_t* Bt; int M, N, K, Kl; };

struct StaticOrder {
    int nM, nN, nwg, G, c;
    __host__ __device__ void init(int M, int N, int G_, int c_) { nM = M / BM; nN = N / BM; nwg = nM * nN; G = G_; c = c_; }
    __host__ __device__ bool next(int i, Unit& u) const {
        const long L = (long)i * G + c; if (L >= nwg) return false;
        int wgid = (int)L; { const int q = nwg / NXCD, r = nwg % NXCD, xcd = wgid % NXCD, off = wgid / NXCD; wgid = (xcd < r ? xcd * (q + 1) : r * (q + 1) + (xcd - r) * q) + off; }
        const int nig = WGM * nN, gid = wgid / nig, fm = gid * WGM, gsz = (nM - fm) < WGM ? (nM - fm) : WGM;
        u.pm = fm + ((wgid % nig) % gsz); u.pn = (wgid % nig) / gsz; return true;
    }
    __device__ __forceinline__ void a_ready(const Unit&) const {}
    __device__ __forceinline__ void done(const Unit&) const {}
};
__device__ __forceinline__ unsigned cvt_pk_bf16(float lo, float hi) { unsigned r; asm volatile("v_cvt_pk_bf16_f32 %0, %1, %2" : "=v"(r) : "v"(lo), "v"(hi)); return r; }
typedef float f32x2 __attribute__((ext_vector_type(2)));
__device__ __forceinline__ float silu_f(float x) { return x * __builtin_amdgcn_rcpf(1.0f + __builtin_amdgcn_exp2f(-1.4426950408889634f * x)); }
__device__ __forceinline__ float sigmoid_f(float x) { return __builtin_amdgcn_rcpf(1.0f + __builtin_amdgcn_exp2f(-1.4426950408889634f * x)); }
__device__ __forceinline__ u32x4 pack8_bf16(f32x4 a, f32x4 b) { u32x4 w; w.x = cvt_pk_bf16(a[0], a[1]); w.y = cvt_pk_bf16(a[2], a[3]); w.z = cvt_pk_bf16(b[0], b[1]); w.w = cvt_pk_bf16(b[2], b[3]); return w; }

__device__ __forceinline__ void load_rstd(const PG8_LAS float* tab, int row0, float (&rs)[2][4]) {
#pragma unroll
    for (int ai = 0; ai < 2; ++ai)
#pragma unroll
        for (int m = 0; m < 4; ++m) rs[ai][m] = tab[(row0 + ai * HALF + m * 16) & 2047];
}
struct EpiSwiGLU {
    static constexpr bool PERM = true, AFTER_DRAIN = false;
    bf16_t* O; int ldc; const PG8_LAS float* rtab;
    __device__ __forceinline__ void operator()(const f32x4 (&acc)[2][2][4][2], const Unit& u, int wr, int wc, int fr, int fq) const {
        const int row0 = u.pm * BM + wr * 64 + fr, col0 = u.pn * 128 + wc * 32 + 8 * fq;
        float rs[2][4]; load_rstd(rtab, row0, rs);
        for (int rep_ = 0; rep_ < 1 + PROBE_EPI; ++rep_)
#pragma unroll
        for (int ai = 0; ai < 2; ++ai)
#pragma unroll
            for (int m = 0; m < 4; ++m) {
                asm volatile("" ::: "memory");
                bf16_t* rowp = O + (size_t)(row0 + ai * HALF + m * 16) * ldc + col0;
                f32x4 v0, v1;
#pragma unroll
                for (int j = 0; j < 4; ++j) { const float r_ = rs[ai][m]; v0[j] = silu_f(acc[ai][0][m][0][j] * r_) * (acc[ai][1][m][0][j] * r_); v1[j] = silu_f(acc[ai][0][m][1][j] * r_) * (acc[ai][1][m][1][j] * r_); }
                *(u32x4*)rowp = pack8_bf16(v0, v1);
            }
    }
};
struct EpiRes {
    static constexpr bool PERM = true, AFTER_DRAIN = false;
    const float* base32; bf16_t* xr; int ldc; float scale; float* ssq;
    __device__ __forceinline__ void operator()(const f32x4 (&acc)[2][2][4][2], const Unit& u, int wr, int wc, int fr, int fq) const {
        const int row0 = u.pm * BM + wr * 64 + fr, col0 = u.pn * BM + wc * 32 + 8 * fq;
        if (base32) {
#pragma unroll
            for (int ai = 0; ai < 2; ++ai) {
                f32x4 bv[4][2][2];
#pragma unroll
                for (int m = 0; m < 4; ++m) { const size_t off = (size_t)(row0 + ai * HALF + m * 16) * ldc + col0;
#pragma unroll
                    for (int bj = 0; bj < 2; ++bj)
#pragma unroll
                        for (int n = 0; n < 2; ++n) bv[m][bj][n] = *(const f32x4*)(base32 + off + bj * HALF + n * 4); }
#pragma unroll
                for (int m = 0; m < 4; ++m) { const size_t off = (size_t)(row0 + ai * HALF + m * 16) * ldc + col0; float ss = 0.f;
#pragma unroll
                    for (int bj = 0; bj < 2; ++bj) { const f32x4 x0 = bv[m][bj][0] + acc[ai][bj][m][0] * scale, x1 = bv[m][bj][1] + acc[ai][bj][m][1] * scale; *(u32x4*)(xr + off + bj * HALF) = pack8_bf16(x0, x1);
                        ss += ((x0[0] * x0[0] + x0[1] * x0[1]) + (x0[2] * x0[2] + x0[3] * x0[3])) + ((x1[0] * x1[0] + x1[1] * x1[1]) + (x1[2] * x1[2] + x1[3] * x1[3])); }
                    ss += __shfl_xor(ss, 16); ss += __shfl_xor(ss, 32); if (fq == 0) ssq[(size_t)(row0 + ai * HALF + m * 16) * 32 + u.pn * 4 + wc] = ss; }
                asm volatile("" ::: "memory");
            }
        } else {
            u32x4 bb[2][4][2];
#pragma unroll
            for (int ai = 0; ai < 2; ++ai)
#pragma unroll
                for (int m = 0; m < 4; ++m) { const size_t off = (size_t)(row0 + ai * HALF + m * 16) * ldc + col0;
#pragma unroll
                    for (int bj = 0; bj < 2; ++bj) bb[ai][m][bj] = *(const u32x4*)(xr + off + bj * HALF); }
#pragma unroll
            for (int ai = 0; ai < 2; ++ai)
#pragma unroll
                for (int m = 0; m < 4; ++m) { const size_t off = (size_t)(row0 + ai * HALF + m * 16) * ldc + col0; float ss = 0.f;
#pragma unroll
                    for (int bj = 0; bj < 2; ++bj) { const u32x4 w = bb[ai][m][bj];
                        const f32x4 b0 = {__uint_as_float(w.x << 16), __uint_as_float(w.x & 0xffff0000u), __uint_as_float(w.y << 16), __uint_as_float(w.y & 0xffff0000u)};
                        const f32x4 b1 = {__uint_as_float(w.z << 16), __uint_as_float(w.z & 0xffff0000u), __uint_as_float(w.w << 16), __uint_as_float(w.w & 0xffff0000u)};
                        const f32x4 x0 = b0 + acc[ai][bj][m][0] * scale, x1 = b1 + acc[ai][bj][m][1] * scale; *(u32x4*)(xr + off + bj * HALF) = pack8_bf16(x0, x1);
                        ss += ((x0[0] * x0[0] + x0[1] * x0[1]) + (x0[2] * x0[2] + x0[3] * x0[3])) + ((x1[0] * x1[0] + x1[1] * x1[1]) + (x1[2] * x1[2] + x1[3] * x1[3])); }
                    ss += __shfl_xor(ss, 16); ss += __shfl_xor(ss, 32); if (fq == 0) ssq[(size_t)(row0 + ai * HALF + m * 16) * 32 + u.pn * 4 + wc] = ss; }
        }
    }
};
struct EpiProj {
    static constexpr bool PERM = true, AFTER_DRAIN = false;
    bf16_t* P; float* gates; const float* rc; const float* rs; const PG8_LAS float* rtab;
    __device__ __forceinline__ void operator()(const f32x4 (&acc_)[2][2][4][2], const Unit& u, int wr, int wc, int fr, int fq) const {
        const int row0 = u.pm * BM + wr * 64 + fr, pn = u.pn;
        float rsd[2][4]; load_rstd(rtab, row0, rsd);
        f32x4 acc[2][2][4][2];
#pragma unroll
        for (int ai = 0; ai < 2; ++ai)
#pragma unroll
            for (int bj = 0; bj < 2; ++bj)
#pragma unroll
                for (int m = 0; m < 4; ++m)
#pragma unroll
                    for (int n = 0; n < 2; ++n) acc[ai][bj][m][n] = acc_[ai][bj][m][n] * rsd[ai][m];
        if (pn == 22) {
            if (wc == 0 && fq < 3) {
#pragma unroll
                for (int ai = 0; ai < 2; ++ai)
#pragma unroll
                    for (int m = 0; m < 4; ++m) { float* gp = gates + (size_t)(row0 + ai * HALF + m * 16) * 32 + 8 * fq;
#pragma unroll
                        for (int n = 0; n < 2; ++n) { f32x4 v;
#pragma unroll
                            for (int j = 0; j < 4; ++j) v[j] = sigmoid_f(acc[ai][0][m][n][j]);
                            *(f32x4*)(gp + 4 * n) = v; } }
            }
        } else if (is_rope_tile(pn)) {
            const int hp = wc >> 1, d0 = 32 * (wc & 1) + 8 * fq;
#pragma unroll
            for (int ai = 0; ai < 2; ++ai)
#pragma unroll
                for (int m = 0; m < 4; ++m) { const int row = row0 + ai * HALF + m * 16, t = row & (TSEQ - 1);
                    const f32x4 c0 = *(const f32x4*)(rc + t * 64 + d0), c1 = *(const f32x4*)(rc + t * 64 + d0 + 4), s0 = *(const f32x4*)(rs + t * 64 + d0), s1 = *(const f32x4*)(rs + t * 64 + d0 + 4);
                    const f32x4 x1a = acc[ai][0][m][0], x1b = acc[ai][0][m][1], x2a = acc[ai][1][m][0], x2b = acc[ai][1][m][1];
                    const f32x4 o1a = x1a * c0 - x2a * s0, o1b = x1b * c1 - x2b * s1, o2a = x2a * c0 + x1a * s0, o2b = x2b * c1 + x1b * s1;
                    bf16_t* pp = P + (size_t)row * LDP + pn * 256 + hp * 128 + d0;
                    *(u32x4*)pp = pack8_bf16(o1a, o1b); *(u32x4*)(pp + 64) = pack8_bf16(o2a, o2b); }
        } else {
#pragma unroll
            for (int ai = 0; ai < 2; ++ai)
#pragma unroll
                for (int m = 0; m < 4; ++m) { bf16_t* pp = P + (size_t)(row0 + ai * HALF + m * 16) * LDP + pn * 256 + wc * 32 + 8 * fq;
#pragma unroll
                    for (int bj = 0; bj < 2; ++bj) *(u32x4*)(pp + bj * HALF) = pack8_bf16(acc[ai][bj][m][0], acc[ai][bj][m][1]); }
        }
    }
};
struct EpiSiluH {
    static constexpr bool PERM = true, AFTER_DRAIN = false;
    bf16_t* H;
    __device__ __forceinline__ void operator()(const f32x4 (&acc)[2][2][4][2], const Unit& u, int wr, int wc, int fr, int fq) const {
        const int row0 = u.pm * BM + wr * 64 + fr;
#pragma unroll
        for (int ai = 0; ai < 2; ++ai)
#pragma unroll
            for (int m = 0; m < 4; ++m) { bf16_t* pp = H + (size_t)((row0 + ai * HALF + m * 16) & 2047) * 512 + u.pn * 256 + wc * 32 + 8 * fq;
#pragma unroll
                for (int bj = 0; bj < 2; ++bj) { f32x4 v0, v1;
#pragma unroll
                    for (int j = 0; j < 4; ++j) { v0[j] = silu_f(acc[ai][bj][m][0][j]); v1[j] = silu_f(acc[ai][bj][m][1][j]); }
                    *(u32x4*)(pp + bj * HALF) = pack8_bf16(v0, v1); } }
    }
};
struct EpiKCVC {
    static constexpr bool PERM = true, AFTER_DRAIN = false;
    bf16_t* KC; bf16_t* VCT;
    __device__ __forceinline__ void operator()(const f32x4 (&acc)[2][2][4][2], const Unit& u, int wr, int wc, int fr, int fq) const {
        const int row0 = u.pm * BM + wr * 64 + fr, c0 = wc * 32 + 8 * fq;
#pragma unroll
        for (int ai = 0; ai < 2; ++ai)
#pragma unroll
            for (int m = 0; m < 4; ++m) { const int row = row0 + ai * HALF + m * 16, bg = row >> 7, n = row & 127;
                *(u32x4*)(KC + (size_t)row * 128 + c0) = pack8_bf16(acc[ai][0][m][0], acc[ai][0][m][1]);
#pragma unroll
                for (int nn = 0; nn < 2; ++nn)
#pragma unroll
                    for (int j = 0; j < 4; ++j) { const float v = acc[ai][1][m][nn][j]; VCT[((size_t)bg * 128 + c0 + 4 * nn + j) * 128 + n] = (bf16_t)(cvt_pk_bf16(v, v) & 0xffffu); } }
    }
};
struct EpiAtomicH {
    static constexpr bool PERM = false, AFTER_DRAIN = false;
    float* H;
    __device__ __forceinline__ void operator()(const f32x4 (&acc)[2][2][4][2], const Unit& u, int wr, int wc, int fr, int fq) const {
        const int row0 = u.pm * BM + wr * 64 + fr, col0 = u.pn * 256 + wc * 32 + 4 * fq; float* Hs = H + (size_t)(u.ko >> 10) * (2048 * 512);
#pragma unroll
        for (int ai = 0; ai < 2; ++ai)
#pragma unroll
            for (int m = 0; m < 4; ++m) { float* rp = Hs + (size_t)((row0 + ai * HALF + m * 16) & 2047) * 512 + col0;
#pragma unroll
                for (int bj = 0; bj < 2; ++bj)
#pragma unroll
                    for (int n = 0; n < 2; ++n) *(f32x4*)(rp + bj * HALF + n * 16) = acc[ai][bj][m][n]; }
    }
};
struct SplitOrder {
    int c;
    __device__ bool next(int i, Unit& u) const { if (i > 0 || c >= 128) return false; u.pm = c >> 3; u.pn = c >> 6; u.ko = (c & 7) * 512 * 2; return true; }
    __device__ __forceinline__ void a_ready(const Unit&) const {}
    __device__ __forceinline__ void done(const Unit&) const {}
};
struct HotOrder {
    int nwg, G, c;
    __device__ bool next(int i, Unit& u) const { const long L = (long)i * G + c; if (L >= nwg) return false; u.pm = 0; u.pn = c & 7; return true; }
    __device__ __forceinline__ void a_ready(const Unit&) const {}
    __device__ __forceinline__ void done(const Unit&) const {}
};
struct DiagOrder {
    int c;
    __device__ bool next(int i, Unit& u) const { if (i > 0 || c >= 16) return false; u.pm = c; u.pn = c >> 3; return true; }
    __device__ __forceinline__ void a_ready(const Unit&) const {}
    __device__ __forceinline__ void done(const Unit&) const {}
};
template <class Epi, class Sched, bool STAMP = false>
__device__ __forceinline__ void gemm_phase(PG8_LAS unsigned char* lds, const Gemm g, const Sched& S, const Epi& E, unsigned long long* stamps) {
    const int tid = opaque_tid(), wid = __builtin_amdgcn_readfirstlane(tid >> 6), lane = tid & 63, wr = wid >> 2, wc = wid & 3, fr = lane & 15, fq = lane >> 4;
    const int K = g.K, nt = (g.Kl ? g.Kl : K) / BK;
    int ts_lo = 0, ts_hi = 0, nts = 0; const unsigned long long rt_entry = STAMP ? (unsigned long long)wall_clock64() : 0ull;
#define PG8_STAMP() do { if (STAMP && wid == 0 && nts < 64) { const unsigned long long _c = (unsigned long long)clock64(); \
        ts_lo = (lane == nts) ? (int)(unsigned)_c : ts_lo; ts_hi = (lane == nts) ? (int)(unsigned)(_c >> 32) : ts_hi; ++nts; } } while (0)
    PG8_STAMP();
    unsigned voffA[2], voffB[2];
#pragma unroll
    for (int i = 0; i < 2; ++i) { int R, C; stage_rc(tid * 16 + i * 8192, R, C); const int Rb = Epi::PERM ? ((R & ~31) + perm32(R & 31)) : R;
        voffA[i] = (unsigned)(R * K + C) * 2u; voffB[i] = (unsigned)(Rb * K + C) * 2u; }
    const size_t kstep = (size_t)(BK * 2);
    const size_t hstep = (size_t)HALF * K * 2;
    const size_t tstep = 2 * hstep;
    const unsigned ldsw = (unsigned)wid * 1024u;
    const int aoff = lds_byte(wr * 64 + fr, fq * 8), boff = lds_byte(wc * 32 + fr, fq * 8);
#define PG8_SA(b, h) (((b) * 2 + (h)) * HTB)
#define PG8_SB(b, h) ((4 + (b) * 2 + (h)) * HTB)
#define PG8_STAGE(bufoff, gbase, voff) do { _Pragma("unroll") for (int _i = 0; _i < 2; ++_i) \
        __builtin_amdgcn_global_load_lds((const unsigned*)((const char*)(gbase) + (voff)[_i]), (PG8_LAS unsigned*)(lds + (bufoff) + ldsw + _i * 8192), 16, 0, 0); } while (0)
#define PG8_LDA(dst, b, h) do { _Pragma("unroll") for (int m = 0; m < 4; ++m) _Pragma("unroll") for (int k = 0; k < 2; ++k) dst[m][k] = *(const PG8_LAS bf16x8*)(lds + PG8_SA(b, h) + aoff + m * 2048 + k * 1024); } while (0)
#define PG8_LDB(dst, b, h) do { _Pragma("unroll") for (int n = 0; n < 2; ++n) _Pragma("unroll") for (int k = 0; k < 2; ++k) dst[n][k] = *(const PG8_LAS bf16x8*)(lds + PG8_SB(b, h) + boff + n * 2048 + k * 1024); } while (0)
#define PG8_MMA(ai, bj, At, Bt) do { __builtin_amdgcn_s_setprio(1); _Pragma("unroll") for (int m = 0; m < 4; ++m) _Pragma("unroll") for (int n = 0; n < 2; ++n) _Pragma("unroll") for (int k = 0; k < 2; ++k) \
        acc[ai][bj][m][n] = __builtin_amdgcn_mfma_f32_16x16x32_bf16(Bt[n][k], At[m][k], acc[ai][bj][m][n], 0, 0, 0); __builtin_amdgcn_s_setprio(0); } while (0)
#define PG8_WAIT_V(n) asm volatile("s_waitcnt vmcnt(" #n ")" ::: "memory")
#define PG8_WAIT_L(n) asm volatile("s_waitcnt lgkmcnt(" #n ")" ::: "memory")
#define PG8_BAR __builtin_amdgcn_s_barrier()
#define PG8_SCHED __builtin_amdgcn_sched_barrier(0)
    Unit cur, nxt; int ui = 0;
    if (!S.next(0, cur)) return;
    f32x4 acc[2][2][4][2];
#pragma unroll
    for (int a = 0; a < 2; ++a)
#pragma unroll
        for (int b = 0; b < 2; ++b)
#pragma unroll
            for (int m = 0; m < 4; ++m)
#pragma unroll
                for (int n = 0; n < 2; ++n) acc[a][b][m][n] = (f32x4){0.f, 0.f, 0.f, 0.f};
    bf16x8 At[4][2], B0[2][2], B1[2][2];
    const char* cA = (const char*)g.A + (size_t)cur.pm * tstep + cur.ko; const char* cB = (const char*)g.Bt + (size_t)cur.pn * tstep + cur.ko;
    S.a_ready(cur);
    PG8_STAGE(PG8_SB(0, 0), cB, voffB); PG8_STAGE(PG8_SA(0, 0), cA, voffA); PG8_STAGE(PG8_SB(0, 1), cB + hstep, voffB); PG8_STAGE(PG8_SA(0, 1), cA + hstep, voffA);
    if (wr == 1) PG8_BAR;
    PG8_WAIT_V(4); PG8_BAR;
    PG8_STAGE(PG8_SB(1, 0), cB + kstep, voffB); PG8_STAGE(PG8_SA(1, 0), cA + kstep, voffA); PG8_STAGE(PG8_SB(1, 1), cB + hstep + kstep, voffB);
    PG8_WAIT_V(6); PG8_BAR;
    PG8_STAMP();
    for (;;) {
        const bool has_next = S.next(ui + 1, nxt);
        const char* nA = has_next ? (const char*)g.A + (size_t)nxt.pm * tstep + nxt.ko : cA; const char* nB = has_next ? (const char*)g.Bt + (size_t)nxt.pn * tstep + nxt.ko : cB;
        for (int t = 0; t < nt; t += 2) {
            const bool last = (t == nt - 2);
            const char* a1 = cA + (size_t)(t + 1) * kstep;
            const char* a2 = last ? nA : cA + (size_t)(t + 2) * kstep; const char* b2 = last ? nB : cB + (size_t)(t + 2) * kstep;
            const char* a3 = a2 + kstep; const char* b3 = b2 + kstep;
            if (last && has_next) S.a_ready(nxt);
            PG8_LDB(B0, 0, 0); PG8_SCHED; PG8_LDA(At, 0, 0); PG8_STAGE(PG8_SA(1, 1), a1 + hstep, voffA);
            PG8_WAIT_L(8); PG8_BAR; PG8_WAIT_L(0); PG8_MMA(0, 0, At, B0); PG8_BAR; PG8_SCHED;
            PG8_LDB(B1, 0, 1); PG8_STAGE(PG8_SB(0, 0), b2, voffB);
            PG8_BAR; PG8_WAIT_L(0); PG8_MMA(0, 1, At, B1); PG8_BAR;
            PG8_LDA(At, 0, 1); PG8_STAGE(PG8_SA(0, 0), a2, voffA);
            PG8_BAR; PG8_WAIT_L(0); PG8_MMA(1, 0, At, B0); PG8_BAR; PG8_SCHED;
            PG8_STAGE(PG8_SB(0, 1), b2 + hstep, voffB);
            PG8_WAIT_V(6); PG8_BAR; PG8_MMA(1, 1, At, B1); PG8_BAR;
            PG8_LDB(B0, 1, 0); PG8_SCHED; PG8_LDA(At, 1, 0); PG8_STAGE(PG8_SA(0, 1), a2 + hstep, voffA);
            PG8_WAIT_L(8); PG8_BAR; PG8_WAIT_L(0); PG8_MMA(0, 0, At, B0); PG8_BAR; PG8_SCHED;
            PG8_LDB(B1, 1, 1); PG8_STAGE(PG8_SB(1, 0), b3, voffB);
            PG8_BAR; PG8_WAIT_L(0); PG8_MMA(0, 1, At, B1); PG8_BAR;
            PG8_LDA(At, 1, 1); PG8_STAGE(PG8_SA(1, 0), a3, voffA);
            PG8_BAR; PG8_WAIT_L(0); PG8_MMA(1, 0, At, B0); PG8_BAR; PG8_SCHED;
            PG8_STAGE(PG8_SB(1, 1), b3 + hstep, voffB);
            PG8_WAIT_V(6); PG8_BAR; PG8_MMA(1, 1, At, B1); PG8_BAR;
        }
        PG8_STAMP();
        if constexpr (!Epi::AFTER_DRAIN) { E(acc, cur, wr, wc, fr, fq); S.done(cur); }
        PG8_STAMP();
        if (!has_next) break;
#pragma unroll
        for (int a = 0; a < 2; ++a)
#pragma unroll
            for (int b = 0; b < 2; ++b)
#pragma unroll
                for (int m = 0; m < 4; ++m)
#pragma unroll
                    for (int n = 0; n < 2; ++n) acc[a][b][m][n] = (f32x4){0.f, 0.f, 0.f, 0.f};
        cur = nxt; cA = nA; cB = nB; ++ui;
    }
    PG8_WAIT_V(0);
    if (wr == 0) PG8_BAR;
    PG8_BAR;
    if constexpr (Epi::AFTER_DRAIN) { E.fused(acc, cur, wr, wc, fr, fq, lds, wid, lane); S.done(cur); }
    PG8_STAMP();
    if (STAMP && wid == 0) { stamps[lane] = lane < nts ? (((unsigned long long)(unsigned)ts_hi << 32) | (unsigned)ts_lo) : 0ull;
        if (lane == 62) stamps[62] = rt_entry; if (lane == 63) stamps[63] = (unsigned long long)wall_clock64(); }
#undef PG8_STAMP
#undef PG8_SA
#undef PG8_SB
#undef PG8_STAGE
#undef PG8_LDA
#undef PG8_LDB
#undef PG8_MMA
#undef PG8_WAIT_V
#undef PG8_WAIT_L
#undef PG8_BAR
#undef PG8_SCHED
}
}
namespace att {
constexpr int D = 128; constexpr float THR = 8.f; constexpr bool WSKIP = false; constexpr int LDQ = LDP, LDK = LDP, LDO = 1024;
constexpr float SCALE = 0.08838834764831845f;
constexpr int NW = 8, QBLK = 32, KVBLK = 64, QB = NW * QBLK;
constexpr int SHM_V = KVBLK * D * 2, SHM_K = KVBLK * D * 2;
constexpr int LDS_BYTES = 2 * SHM_V + 2 * SHM_K + NW * 64 * 4;

using bf16 = __hip_bfloat16;
typedef short bf16x8 __attribute__((ext_vector_type(8)));
typedef short s16x4 __attribute__((ext_vector_type(4)));
typedef float f32x16 __attribute__((ext_vector_type(16)));
typedef float f32x4 __attribute__((ext_vector_type(4)));
typedef unsigned u32x4 __attribute__((ext_vector_type(4)));
template <class A, class Bt> struct same_t { static constexpr bool v = false; };
template <class A> struct same_t<A, A> { static constexpr bool v = true; };

#define KSWZ(row, colB) ((row) * 256 + ((colB) ^ (((row) & 7) << 4)))
#define SBAR() __builtin_amdgcn_sched_barrier(0)
__device__ __forceinline__ int v_st(int k, int c) { const int kk = (k & ~0xC) | ((k & 4) << 1) | ((k & 8) >> 1); return ((kk >> 3) * 4 + (c >> 5)) * 512 + ((kk & 7) * 32 + (c & 31)) * 2; }
__device__ __forceinline__ int v_rd_base(int lane) { return ((lane & 3) << 3) | (((lane >> 2) & 3) << 6) | (((lane >> 4) & 1) << 5) | (((lane >> 5) & 1) << 8); }
constexpr int v_rd_off(int d0, int ks, int half) { return d0 * 512 + ks * 4096 + half * 2048; }
__device__ __forceinline__ int crow(int r, int hi) { return (r & 3) + 8 * (r >> 2) + 4 * hi; }
__device__ __forceinline__ unsigned cvtpk(float lo, float hi) {
    unsigned r; asm volatile("v_cvt_pk_bf16_f32 %0, %1, %2" : "=v"(r) : "v"(lo), "v"(hi)); return r;
}
__device__ __forceinline__ bf16x8 pack8(f32x4 a, f32x4 b) {
    u32x4 w = {cvtpk(a[0], a[1]), cvtpk(a[2], a[3]), cvtpk(b[0], b[1]), cvtpk(b[2], b[3])};
    return *reinterpret_cast<bf16x8*>(&w);
}
template <class T> __device__ __forceinline__ bf16x8 load8(const T* p) {
    if constexpr (same_t<T, float>::v) { return pack8(*(const f32x4*)p, *(const f32x4*)(p + 4)); }
    else { return *reinterpret_cast<const bf16x8*>(p); }
}
__device__ __forceinline__ void mask_tile(f32x16& p0, f32x16& p1, int dq, unsigned W) {
    const float NEG = -__builtin_inff();
#pragma unroll
    for (int r = 0; r < 16; ++r) {
        const int c = (r & 3) + 8 * (r >> 2);
        if ((unsigned)(dq - c) >= W) p0[r] = NEG;
        if ((unsigned)(dq - c - 32) >= W) p1[r] = NEG;
    }
}
__device__ __forceinline__ void partialSM(f32x16& p0, f32x16& p1, float& m_reg, float& mn, float& alpha) {
    float pmax = p0[0]; for (int r = 1; r < 16; ++r) pmax = fmaxf(pmax, p0[r]); for (int r = 0; r < 16; ++r) pmax = fmaxf(pmax, p1[r]);
    { auto rr = __builtin_amdgcn_permlane32_swap(__float_as_uint(pmax), __float_as_uint(pmax), false, false);
      pmax = fmaxf(__uint_as_float(rr[0]), __uint_as_float(rr[1])); }
    constexpr float C2 = 1.4426950408889634f * SCALE;
    if (__builtin_expect(__all((pmax - m_reg) * SCALE <= THR), 1)) { mn = m_reg; alpha = 1.f; }
    else { mn = fmaxf(m_reg, pmax); alpha = __builtin_amdgcn_exp2f((m_reg - mn) * C2); m_reg = mn; }
    const float mnL = -mn * C2;
    for (int r = 0; r < 16; ++r) p0[r] = fmaf(p0[r], C2, mnL); for (int r = 0; r < 16; ++r) p1[r] = fmaf(p1[r], C2, mnL);
    for (int r = 0; r < 16; ++r) p0[r] = __builtin_amdgcn_exp2f(p0[r]);
}
__device__ __forceinline__ void finishSM(f32x16& p0, f32x16& p1, float alpha, float& l_reg, bf16x8& pa0, bf16x8& pa1, bf16x8& pa2, bf16x8& pa3) {
    for (int r = 0; r < 16; ++r) p1[r] = __builtin_amdgcn_exp2f(p1[r]);
    float ps = 0; for (int r = 0; r < 16; ++r) ps += p0[r]; for (int r = 0; r < 16; ++r) ps += p1[r];
    { auto rr = __builtin_amdgcn_permlane32_swap(__float_as_uint(ps), __float_as_uint(ps), false, false);
      ps = __uint_as_float(rr[0]) + __uint_as_float(rr[1]); }
    l_reg = l_reg * alpha + ps;
#define PK4(P, B_, OUT) do { unsigned a0 = cvtpk(P[B_+0], P[B_+1]), a1 = cvtpk(P[B_+2], P[B_+3]);                          \
        unsigned b0 = cvtpk(P[B_+4], P[B_+5]), b1 = cvtpk(P[B_+6], P[B_+7]);                                             \
        auto r0 = __builtin_amdgcn_permlane32_swap(a0, b0, false, false); auto r1 = __builtin_amdgcn_permlane32_swap(a1, b1, false, false); \
        u32x4 w = {r0[0], r1[0], r0[1], r1[1]}; OUT = *reinterpret_cast<bf16x8*>(&w); } while (0)
    PK4(p0, 0, pa0); PK4(p0, 8, pa1); PK4(p1, 0, pa2); PK4(p1, 8, pa3);
#undef PK4
}
template <int KB, bool SK>
__device__ __forceinline__ void qkt(f32x16& p0, f32x16& p1, const char* K_lds, int r32, int hi, const bf16x8* qr, bool act) {
    if (SK && !act) { const float NEG = -__builtin_inff();
#pragma unroll
        for (int r = 0; r < 16; ++r) { p0[r] = NEG; p1[r] = NEG; } return; }
    p0 = f32x16{}; p1 = f32x16{};
    const char* kb[4];
#pragma unroll
    for (int dd = 0; dd < 4; ++dd) kb[dd] = K_lds + KB * SHM_K + KSWZ(r32, (dd * 16 + hi * 8) * 2);
#pragma unroll
    for (int d0 = 0; d0 < 8; ++d0) { const char* a = kb[d0 & 3] + (d0 >> 2) * 128;
        bf16x8 b0 = *reinterpret_cast<const bf16x8*>(a);
        bf16x8 b1 = *reinterpret_cast<const bf16x8*>(a + 32 * 256);
        p0 = __builtin_amdgcn_mfma_f32_32x32x16_bf16(b0, qr[d0], p0, 0, 0, 0);
        p1 = __builtin_amdgcn_mfma_f32_32x32x16_bf16(b1, qr[d0], p1, 0, 0, 0); }
}
template <int VB, bool SK>
__device__ __forceinline__ void pv_tile(f32x16* o, int vb0, bf16x8 pa0, bf16x8 pa1, bf16x8 pa2, bf16x8 pa3, bool act) {
    if (SK && !act) return;
#define TRRD(dst, off) asm volatile("ds_read_b64_tr_b16 %0, %1 offset:%2" : "=&v"(dst) : "v"(vb0), "i"(off) : "memory")
#define PV_D0(d0) do { s16x4 l0, l1, l2, l3, h0, h1, h2, h3; constexpr int b_ = VB * SHM_V + v_rd_off(d0, 0, 0);     \
        TRRD(l0, b_); TRRD(h0, b_ + 2048); TRRD(l1, b_ + 4096); TRRD(h1, b_ + 6144); TRRD(l2, b_ + 8192); TRRD(h2, b_ + 10240); TRRD(l3, b_ + 12288); TRRD(h3, b_ + 14336); \
        asm volatile("s_waitcnt lgkmcnt(0)" ::: "memory"); SBAR();                 \
        o[d0] = __builtin_amdgcn_mfma_f32_32x32x16_bf16(pa0, (bf16x8){l0[0], l0[1], l0[2], l0[3], h0[0], h0[1], h0[2], h0[3]}, o[d0], 0, 0, 0);   \
        o[d0] = __builtin_amdgcn_mfma_f32_32x32x16_bf16(pa1, (bf16x8){l1[0], l1[1], l1[2], l1[3], h1[0], h1[1], h1[2], h1[3]}, o[d0], 0, 0, 0);   \
        o[d0] = __builtin_amdgcn_mfma_f32_32x32x16_bf16(pa2, (bf16x8){l2[0], l2[1], l2[2], l2[3], h2[0], h2[1], h2[2], h2[3]}, o[d0], 0, 0, 0);   \
        o[d0] = __builtin_amdgcn_mfma_f32_32x32x16_bf16(pa3, (bf16x8){l3[0], l3[1], l3[2], l3[3], h3[0], h3[1], h3[2], h3[3]}, o[d0], 0, 0, 0); } while (0)
    PV_D0(0); PV_D0(1); PV_D0(2); PV_D0(3);
#undef PV_D0
#undef TRRD
}

template <class TIn, class TOut> struct BlockRef { const char* base; unsigned qo, ko, vo, oo, so; int P0; int W;
    __device__ __forceinline__ const TIn* Qp() const { return (const TIn*)(base + qo); }
    __device__ __forceinline__ const TIn* Kp() const { return (const TIn*)(base + ko); }
    __device__ __forceinline__ const TIn* Vp() const { return (const TIn*)(base + vo); }
    __device__ __forceinline__ TOut* Op() const { return (TOut*)(base + oo); }
    __device__ __forceinline__ bool has_sel() const { return so != 0xffffffffu; }
    __device__ __forceinline__ const unsigned* selp() const { return (const unsigned*)(base + so); } };
template <class TIn> struct Seam {
    bf16x8 qr[8];
    bf16x8 st_v0, st_v1, st_k0, st_k1; f32x4 sf0, sf1, sf2, sf3;
    f32x4 tq[16];
};
__device__ __forceinline__ int swa_jlo(int P0, int W) { const int lowk = P0 - W + 1; return lowk > 0 ? lowk / KVBLK : 0; }
#define ROW(p, k0, rr) ((p) + (size_t)(k0) * LDK + (unsigned)((rr) * LDK + sc))
#define VMW() asm volatile("s_waitcnt vmcnt(0)" ::: "memory")
#define VMWN(n) asm volatile("s_waitcnt vmcnt(%0)" :: "i"(n) : "memory")
#define SLOAD_H(Kp, Vp, k0) do { S.st_v0 = load8<TIn>(ROW(Vp, k0, sr)); S.st_v1 = load8<TIn>(ROW(Vp, k0, 32 + sr));              \
                         S.st_k0 = load8<TIn>(ROW(Kp, k0, sr)); S.st_k1 = load8<TIn>(ROW(Kp, k0, 32 + sr)); } while (0)
#define SWRITE_HK(bf) do { *(bf16x8*)(K_lds + (bf) * SHM_K + kws) = S.st_k0; *(bf16x8*)(K_lds + (bf) * SHM_K + kws + 32 * 256) = S.st_k1; } while (0)
#define SWRITE_HV(bf) do { *(bf16x8*)(V_lds + (bf) * SHM_V + vst0) = S.st_v0; *(bf16x8*)(V_lds + (bf) * SHM_V + vst1) = S.st_v1; } while (0)
#define SWRITE_H(bf) do { SWRITE_HV(bf); SWRITE_HK(bf); } while (0)
#define SLOAD_F(p, k0) do { S.sf0 = *(const f32x4*)ROW(p, k0, sr); S.sf1 = *(const f32x4*)(ROW(p, k0, sr) + 4);                \
                            S.sf2 = *(const f32x4*)ROW(p, k0, 32 + sr); S.sf3 = *(const f32x4*)(ROW(p, k0, 32 + sr) + 4); } while (0)
#define SWRITE_KF(bf) do { *(bf16x8*)(K_lds + (bf) * SHM_K + kws) = pack8(S.sf0, S.sf1); *(bf16x8*)(K_lds + (bf) * SHM_K + kws + 32 * 256) = pack8(S.sf2, S.sf3); } while (0)
#define SWRITE_VF(bf) do { *(bf16x8*)(V_lds + (bf) * SHM_V + vst0) = pack8(S.sf0, S.sf1); *(bf16x8*)(V_lds + (bf) * SHM_V + vst1) = pack8(S.sf2, S.sf3); } while (0)
template <class TIn, class TOut>
__device__ __forceinline__ void causal_swa_prime(const BlockRef<TIn, TOut>& cur, char* lds, Seam<TIn>& S) {
    constexpr bool F32 = same_t<TIn, float>::v;
    const int tid = opaque_tid(), wid = __builtin_amdgcn_readfirstlane(tid >> 6), lane = tid & 63, r32 = lane & 31, hi = lane >> 5;
    const int sr = tid >> 4, sc = (tid & 15) * 8, kws = KSWZ(sr, sc * 2); char* K_lds = lds + 2 * SHM_V;
    const int kb0 = swa_jlo(cur.P0, cur.W) * KVBLK;
    for (int d0 = 0; d0 < 8; ++d0) S.qr[d0] = load8<TIn>(cur.Qp() + (size_t)(wid * QBLK) * LDQ + (unsigned)(r32 * LDQ + hi * 8) + d0 * 16);
    if constexpr (F32) { SLOAD_F((const float*)cur.Kp(), kb0); VMW(); SWRITE_KF(0); SBAR(); SLOAD_F((const float*)cur.Vp(), kb0); }
    else { SLOAD_H(cur.Kp(), cur.Vp(), kb0); VMW(); SWRITE_HK(0); }
    __syncthreads();
}
template <class TIn, class TOut>
__device__ __forceinline__ void causal_swa_block(const BlockRef<TIn, TOut>& cur, const BlockRef<TIn, TOut>& nxt, int skv, char* lds, Seam<TIn>& S) {
    constexpr bool F32 = same_t<TIn, float>::v;
    const int tid = opaque_tid(), wid = __builtin_amdgcn_readfirstlane(tid >> 6), lane = tid & 63, r32 = lane & 31, hi = lane >> 5;
    const int W = cur.W;
    const int j_lo = swa_jlo(cur.P0, W);
    const unsigned selw = cur.has_sel() ? cur.selp()[wid * QBLK + r32] : 0xffffffffu;
    int j_hi = (cur.P0 + QB - 1) / KVBLK + 1; if (j_hi > skv / KVBLK) j_hi = skv / KVBLK;
    const int NT = j_hi - j_lo;
    const int kbn = swa_jlo(nxt.P0, nxt.W) * KVBLK;
    const int qlo = cur.P0 + wid * QBLK, qm = qlo + r32 - 4 * hi;
    char* V_lds = lds; char* K_lds = lds + 2 * SHM_V;
    float* ws = (float*)(lds + 2 * SHM_V + 2 * SHM_K) + wid * 64; float* li_l = ws, * al_l = ws + 32;
    float m_reg = -1e30f, l_reg = 0; f32x16 o[4] = {};
    const int sr = tid >> 4, sc = (tid & 15) * 8, vst0 = v_st(sr, sc), vst1 = v_st(32 + sr, sc), kws = KSWZ(sr, sc * 2);
    const int vb0 = (int)(uintptr_t)V_lds + v_rd_base(lane);
    const TIn* Kh = cur.Kp(); const TIn* Vh = cur.Vp();
#define RESC(a) do { if (__any((a) < 1.f)) { if (hi == 0) al_l[r32] = (a); asm volatile("s_waitcnt lgkmcnt(0)" ::: "memory");              \
                     for (int d_ = 0; d_ < 4; ++d_) for (int r = 0; r < 16; ++r) o[d_][r] *= al_l[crow(r, hi)]; } } while (0)
#define KBASE(t) ((j_lo + (t)) * KVBLK)
#define ACT(t) (KBASE(t) <= qlo + QBLK - 1 && KBASE(t) + KVBLK - 1 >= qlo - W + 1)
#define MASKT(P0_, P1_, t) do { const int kb_ = KBASE(t); if ((!SK || ACT(t)) && (kb_ + KVBLK - 1 > qlo || kb_ <= qlo + QBLK - 1 - W)) mask_tile(P0_, P1_, qm - kb_, (unsigned)W); \
        if (cur.has_sel()) { if (!((selw >> (j_lo + (t))) & 1u)) { const float NEG_ = -__builtin_inff(); _Pragma("unroll") for (int r_ = 0; r_ < 16; ++r_) { P0_[r_] = NEG_; P1_[r_] = NEG_; } } } } while (0)
    constexpr int NQL = F32 ? 16 : 8;
    constexpr bool SK = WSKIP && !F32;
#define SEAM_K0() do { VMWN(NQL); if constexpr (F32) { SWRITE_KF(0); SBAR(); SLOAD_F((const float*)nxt.Vp(), kbn); } else { SWRITE_HK(0); } SBAR(); } while (0)
    f32x16 pA0, pA1, pB0, pB1; float mnA, mnB, alA, alB; bf16x8 pa0, pa1, pa2, pa3;
    if constexpr (F32) { VMW(); SWRITE_VF(0); SBAR(); } else { SWRITE_HV(0); SBAR(); }
    if (NT > 1) { if constexpr (F32) SLOAD_F((const float*)Kh, KBASE(1)); else SLOAD_H(Kh, Vh, KBASE(1)); }
    SBAR(); qkt<0, SK>(pA0, pA1, K_lds, r32, hi, S.qr, ACT(0));
    if constexpr (F32) { if (NT > 1) { VMW(); SWRITE_KF(1); SBAR(); SLOAD_F((const float*)Vh, KBASE(1)); } }
    MASKT(pA0, pA1, 0); partialSM(pA0, pA1, m_reg, mnA, alA);
    if (NT > 1) { VMW(); if constexpr (F32) { SWRITE_VF(1); SBAR(); if (NT > 2) SLOAD_F((const float*)Kh, KBASE(2)); } else SWRITE_H(1); }
    __syncthreads();
#define HALF_STEP(PX0, PX1, mnX, alX, PY0, PY1, alY, t, KB, VB, SB) do {                                                      \
        SBAR(); qkt<KB, SK>(PX0, PX1, K_lds, r32, hi, S.qr, ACT(t));                                             \
        finishSM(PY0, PY1, alY, l_reg, pa0, pa1, pa2, pa3); SBAR();                                                           \
        if ((t) + 1 < NT) { if constexpr (F32) { VMW(); SWRITE_KF(SB); SBAR(); SLOAD_F((const float*)Vh, KBASE((t) + 1)); }  \
                            else { SLOAD_H(Kh, Vh, KBASE((t) + 1)); } SBAR(); }                                               \
        pv_tile<VB, SK>(o, vb0, pa0, pa1, pa2, pa3, ACT((t) - 1)); MASKT(PX0, PX1, (t)); partialSM(PX0, PX1, m_reg, mnX, alX);                                        \
        __syncthreads();                                                                                                      \
        if ((t) + 1 < NT) { VMW(); if constexpr (F32) { SWRITE_VF(SB); SBAR(); if ((t) + 2 < NT) SLOAD_F((const float*)Kh, KBASE((t) + 2)); } \
                            else { SWRITE_H(SB); } }                                                                          \
        RESC(alX); __syncthreads(); } while (0)
    for (int t = 1; t + 1 < NT; t += 2) {
        HALF_STEP(pB0, pB1, mnB, alB, pA0, pA1, alA, t, 1, 0, 0);
        HALF_STEP(pA0, pA1, mnA, alA, pB0, pB1, alB, t + 1, 0, 1, 1);
    }
    const bool even = (NT & 1) == 0;
    if (even) { SBAR(); qkt<1, SK>(pB0, pB1, K_lds, r32, hi, S.qr, ACT(NT - 1)); SBAR(); }
#define QROW(e) (nxt.Qp() + (size_t)(wid * QBLK + r32) * LDQ + ((e) >> 1) * 16 + hi * 8 + ((e) & 1) * 4)
    if constexpr (F32) { SLOAD_F((const float*)nxt.Kp(), kbn); SBAR();
#pragma unroll
        for (int e = 0; e < 8; ++e) S.tq[e] = *(const f32x4*)QROW(e); }
    else { SLOAD_H(nxt.Kp(), nxt.Vp(), kbn); SBAR();
#pragma unroll
        for (int d0 = 0; d0 < 8; ++d0) S.qr[d0] = load8<TIn>(nxt.Qp() + (size_t)(wid * QBLK) * LDQ + (unsigned)(r32 * LDQ + hi * 8) + d0 * 16); }
    SBAR();
    finishSM(pA0, pA1, alA, l_reg, pa0, pa1, pa2, pa3); SBAR();
    if constexpr (F32) {
#pragma unroll
        for (int e = 8; e < 16; ++e) S.tq[e] = *(const f32x4*)QROW(e); SBAR(); }
#undef QROW
    pv_tile<0, SK>(o, vb0, pa0, pa1, pa2, pa3, ACT(even ? NT - 2 : NT - 1));
    if (even) { MASKT(pB0, pB1, NT - 1); partialSM(pB0, pB1, m_reg, mnB, alB); __syncthreads(); RESC(alB);
        finishSM(pB0, pB1, alB, l_reg, pa0, pa1, pa2, pa3); SBAR(); pv_tile<1, SK>(o, vb0, pa0, pa1, pa2, pa3, ACT(NT - 1)); }
    SBAR(); SEAM_K0();
    if (hi == 0) li_l[r32] = l_reg; asm volatile("s_waitcnt lgkmcnt(0)" ::: "memory");
    float rli[16];
#pragma unroll
    for (int r = 0; r < 16; ++r) rli[r] = __builtin_amdgcn_rcpf(li_l[crow(r, hi)]);
    TOut* Ow = cur.Op() + (size_t)(wid * QBLK) * LDO;
#pragma unroll
    for (int r = 0; r < 16; ++r) { const int orow = crow(r, hi);
#pragma unroll
        for (int d0 = 0; d0 < 4; ++d0) { const float v = o[d0][r] * rli[r];
            if constexpr (same_t<TOut, float>::v) { Ow[(size_t)orow * LDO + d0 * 32 + r32] = v; }
            else { const float vn = __shfl_xor(v, 1);
                   if ((r32 & 1) == 0) *(unsigned*)(Ow + (size_t)orow * LDO + d0 * 32 + r32) = cvtpk(v, vn); } } }
    if constexpr (F32) {
#pragma unroll
        for (int d0 = 0; d0 < 8; ++d0) S.qr[d0] = pack8(S.tq[2 * d0], S.tq[2 * d0 + 1]); }
    __syncthreads();
#undef RESC
#undef KBASE
#undef ACT
#undef MASKT
#undef SEAM_K0
#undef HALF_STEP
}
#undef ROW
#undef VMW
#undef VMWN
#undef SLOAD_H
#undef SWRITE_HK
#undef SWRITE_HV
#undef SWRITE_H
#undef SLOAD_F
#undef SWRITE_KF
#undef SWRITE_VF

}
typedef unsigned short bf16_t;
typedef short bf16x8 __attribute__((ext_vector_type(8)));
typedef float f32x4 __attribute__((ext_vector_type(4)));
typedef float f32x16 __attribute__((ext_vector_type(16)));
typedef unsigned u32x4 __attribute__((ext_vector_type(4)));
typedef unsigned u32x2 __attribute__((ext_vector_type(2)));
constexpr size_t SZ_WA = (size_t)11264 * 2048 * 2, SZ_WD = (size_t)2048 * 5632 * 2, SZ_WIN = (size_t)NPROJ * 2048 * 2, SZ_WOUT = (size_t)2048 * 2048 * 2,
                 SZ_WC1 = (size_t)512 * 4096 * 2, SZ_WC2 = (size_t)256 * 512 * 2;
constexpr size_t OFF_W1A = 0, OFF_W1D = OFF_W1A + SZ_WA, OFF_W2A = OFF_W1D + SZ_WD, OFF_W2D = OFF_W2A + SZ_WA, OFF_WIN = OFF_W2D + SZ_WD, OFF_WOUT = OFF_WIN + SZ_WIN,
                 OFF_WC1 = OFF_WOUT + SZ_WOUT, OFF_WC2 = OFF_WC1 + SZ_WC1, SZ_LAYER = OFF_WC2 + SZ_WC2;
constexpr size_t SZ_O = (size_t)M_TOK * 1024 * 2;
constexpr size_t WS_HB = 2 * SZ_LAYER, WS_XR = WS_HB  , WS_ACT = WS_HB + (size_t)M_TOK * DM * 2, WS_GATES = WS_ACT + (size_t)M_TOK * DFF * 2, WS_OCMP = WS_GATES + (size_t)M_TOK * 32 * 4,
                 WS_OSLC = WS_OCMP + SZ_O, WS_OWIN = WS_OSLC + SZ_O, WS_OD1 = WS_OWIN + SZ_O, WS_OD2 = WS_OD1 + SZ_O, WS_AKV = WS_OD1  ,
                 WS_HC = WS_OD2 + SZ_O, WS_KC = WS_HC + (size_t)2048 * 512 * 2, WS_VCT = WS_KC + (size_t)16 * 128 * 128 * 2, WS_SELM = WS_VCT + (size_t)16 * 128 * 128 * 2,
                 WS_ROPEC = WS_SELM + (size_t)16 * 2048 * 4, WS_ROPES = WS_ROPEC + (size_t)2048 * 64 * 4, WS_BAR = WS_ROPES + (size_t)2048 * 64 * 4, WS_ITEMS = WS_BAR + 16384, WS_HPRE = WS_ITEMS + (size_t)2048 * 8 * 4, WS_SSQ = WS_HPRE + (size_t)8 * 2048 * 512 * 4, WS_PT = WS_SSQ + (size_t)M_TOK * 32 * 4, WS_END = WS_PT + (size_t)4 * 64 * 256 * 4;
static_assert(SZ_LAYER % 256 == 0 && (size_t)4096 * 4096 * 2 == SZ_O, "layout");

struct Params { const float* in[24]; float* out; unsigned char* ws; };
typedef const __attribute__((address_space(4))) Params* KParamsPtr;

__device__ __forceinline__ unsigned cvtpk2(float lo, float hi) { unsigned r; asm volatile("v_cvt_pk_bf16_f32 %0, %1, %2" : "=v"(r) : "v"(lo), "v"(hi)); return r; }
__device__ __forceinline__ float bf_lo(unsigned w) { return __uint_as_float(w << 16); }
__device__ __forceinline__ float bf_hi(unsigned w) { return __uint_as_float(w & 0xffff0000u); }

__device__ __forceinline__ void tc_tile4(const float* __restrict__ src, int ld_src, int col0, int ncv, int ks0, bf16_t* __restrict__ dst, int ld_dst, int row0, int kd0, float* tile, const float* __restrict__ gk = nullptr) {
    const int tid = opaque_tid(), cc = tid & 63, kb = tid >> 6;
    float v[32];
    const bool ok = ks0 >= 0 && cc < ncv;
    const float* sp = src + (size_t)((ks0 >= 0 ? ks0 : 0) + kb) * ld_src + col0 + (cc < ncv ? cc : 0);
#pragma unroll
    for (int i = 0; i < 32; ++i) v[i] = ok ? __builtin_nontemporal_load(sp + (size_t)(8 * i) * ld_src) : 0.f;
    if (gk && ks0 >= 0) {
#pragma unroll
        for (int i = 0; i < 32; ++i) v[i] *= gk[ks0 + kb + 8 * i]; }
#pragma unroll
    for (int i = 0; i < 32; ++i) tile[(kb + 8 * i) * 65 + cc] = v[i];
    __syncthreads();
    const int rr = tid >> 3, kq = (tid & 7) * 8;
#pragma unroll
    for (int jx = 0; jx < 4; ++jx) { const int k0 = kq + 64 * jx; u32x4 w;
        w.x = cvtpk2(tile[(k0 + 0) * 65 + rr], tile[(k0 + 1) * 65 + rr]); w.y = cvtpk2(tile[(k0 + 2) * 65 + rr], tile[(k0 + 3) * 65 + rr]);
        w.z = cvtpk2(tile[(k0 + 4) * 65 + rr], tile[(k0 + 5) * 65 + rr]); w.w = cvtpk2(tile[(k0 + 6) * 65 + rr], tile[(k0 + 7) * 65 + rr]);
        __builtin_nontemporal_store(w, (u32x4*)(dst + (size_t)(row0 + rr) * ld_dst + kd0 + k0)); }
    __syncthreads();
}
__device__ void prep_phase(KParamsPtr pp_, float* tile) {
    const int G = opaque_gx(), bx = opaque_bx();
    for (int l = 0; l < 2; ++l) {
        unsigned char* wl = pp_->ws + (size_t)l * SZ_LAYER;
        for (int f = 0; f < 2; ++f) {
            const float* gate = pp_->in[f ? 20 : 2] + (size_t)l * DM * DFF; const float* up = pp_->in[f ? 21 : 3] + (size_t)l * DM * DFF; const float* down = pp_->in[f ? 22 : 4] + (size_t)l * DM * DFF;
            bf16_t* dA = (bf16_t*)(wl + (f ? OFF_W2A : OFF_W1A)); bf16_t* dD = (bf16_t*)(wl + (f ? OFF_W2D : OFF_W1D)); const float* gn = pp_->in[f ? 19 : 1] + (size_t)l * DM;
            for (int tix = bx; tix < 176 * 8; tix += G) { const int rg = tix >> 3, kg = tix & 7, pp = rg >> 2, q = rg & 3;
                tc_tile4(q < 2 ? gate : up, DFF, 128 * pp + 64 * (q & 1), 64, kg * 256, dA, DM, rg * 64, kg * 256, tile, gn); }
            for (int tix = bx; tix < 32 * 22; tix += G) { const int rg = tix / 22, kg = tix - rg * 22;
                tc_tile4(down, DM, 64 * rg, 64, kg * 256, dD, DFF, rg * 64, kg * 256, tile); }
        }
        { const float* w = pp_->in[6] + (size_t)l * DM * 5656; bf16_t* dst = (bf16_t*)(wl + OFF_WIN); const float* gn = pp_->in[5] + (size_t)l * DM;
          for (int tix = bx; tix < 92 * 8; tix += G) { const int rg = tix >> 3, kg = tix & 7, pn = rg >> 2, q = rg & 3; int col0 = 0, ncv = 64, ks0 = kg * 256;
              if (pn == 22) { if (q == 0) { col0 = 2560; ncv = 24; } else ks0 = -1; }
              else { const int pcol = is_rope_tile(pn) ? 256 * pn + (q & 1) * 128 + 64 * (q >> 1) : 256 * pn + 64 * q; col0 = pcol < 2560 ? pcol : pcol + 24; }
              tc_tile4(w, 5656, col0, ncv, ks0, dst, DM, rg * 64, kg * 256, tile, gn); } }
        { const float* w = pp_->in[18] + (size_t)l * DM * DM; bf16_t* dst = (bf16_t*)(wl + OFF_WOUT);
          for (int tix = bx; tix < 32 * 8; tix += G) { const int rg = tix >> 3, kg = tix & 7; tc_tile4(w, DM, 64 * rg, 64, kg * 256, dst, DM, rg * 64, kg * 256, tile); } }
        { const float* wk = pp_->in[9] + (size_t)l * 4096 * 256; const float* wv = pp_->in[11] + (size_t)l * 4096 * 256; bf16_t* dst = (bf16_t*)(wl + OFF_WC1);
          for (int tix = bx; tix < 8 * 16; tix += G) { const int rg = tix >> 4, kg = tix & 15; tc_tile4(rg < 4 ? wk : wv, 256, 64 * (rg & 3), 64, kg * 256, dst, 4096, rg * 64, kg * 256, tile); } }
        { const float* wk = pp_->in[10] + (size_t)l * 256 * 128; const float* wv = pp_->in[12] + (size_t)l * 256 * 128; bf16_t* dst = (bf16_t*)(wl + OFF_WC2);
          for (int tix = bx; tix < 4 * 2; tix += G) { const int rg = tix >> 1, kg = tix & 1; const int ks0 = (rg < 2) == (kg == 0) ? 0 : -1;
              tc_tile4(rg < 2 ? wk : wv, 128, 64 * (rg & 1), 64, ks0, dst, 512, rg * 64, kg * 256, tile); } }
    }
    { float* PTP = (float*)(pp_->ws + WS_PT); const int tid_ = opaque_tid(), wv = tid_ >> 6, ln = tid_ & 63;
      if (wv < 4) for (int task = bx * 4 + wv; task < 1024; task += G * 4) { const int l = task >> 9, kv = (task >> 8) & 1, hg = (task >> 6) & 3, kc = task & 63;
          const float* pos = pp_->in[kv ? 8 : 7] + (size_t)l * 4096 + kc * 64; const float* w1 = pp_->in[kv ? 11 : 9] + (size_t)l * 4096 * 256 + (size_t)(kc * 64) * 256 + hg * 64 + ln; float a = 0.f;
#pragma unroll 16
          for (int i = 0; i < 64; ++i) a += pos[i] * w1[(size_t)i * 256];
          PTP[(size_t)((l * 2 + kv) * 64 + kc) * 256 + hg * 64 + ln] = a; } }
    float* rc = (float*)(pp_->ws + WS_ROPEC); float* rs = (float*)(pp_->ws + WS_ROPES);
    for (int i = bx * 512 + opaque_tid(); i < TSEQ * 64; i += G * 512) { const int t = i >> 6, d = i & 63;
        const float inv = __builtin_amdgcn_exp2f(-(float)d * 0.20762050593046014f);
        const float ang = (float)t * inv; float rev = ang * 0.15915494309189535f; rev -= floorf(rev);
        rc[i] = __builtin_amdgcn_cosf(rev); rs[i] = __builtin_amdgcn_sinf(rev); }
}

template <bool IN_BF16, bool TO_BF16>
__device__ void rmsnorm_phase(const void* __restrict__ xin, const float* __restrict__ g, bf16_t* __restrict__ ob, float* __restrict__ of) {
    const int tid_ = opaque_tid(); const int wid = tid_ >> 6, lane = tid_ & 63;
    f32x4 gv[8];
#pragma unroll
    for (int i = 0; i < 8; ++i) gv[i] = *(const f32x4*)(g + (lane + 64 * i) * 4);
    for (int row = opaque_bx() * 8 + wid; row < M_TOK; row += opaque_gx() * 8) {
        f32x4 v[8]; float ss = 0.f;
        if (IN_BF16) { const bf16_t* xr = (const bf16_t*)xin + (size_t)row * DM; u32x2 w[8];
#pragma unroll
            for (int i = 0; i < 8; ++i) w[i] = *(const u32x2*)(xr + (lane + 64 * i) * 4);
#pragma unroll
            for (int i = 0; i < 8; ++i) v[i] = (f32x4){bf_lo(w[i].x), bf_hi(w[i].x), bf_lo(w[i].y), bf_hi(w[i].y)}; }
        else { const float* xr = (const float*)xin + (size_t)row * DM;
#pragma unroll
            for (int i = 0; i < 8; ++i) v[i] = *(const f32x4*)(xr + (lane + 64 * i) * 4); }
#pragma unroll
        for (int i = 0; i < 8; ++i) ss += v[i][0] * v[i][0] + v[i][1] * v[i][1] + v[i][2] * v[i][2] + v[i][3] * v[i][3];
#pragma unroll
        for (int o = 32; o >= 1; o >>= 1) ss += __shfl_xor(ss, o);
        const float rstd = 1.0f / sqrtf(ss * (1.0f / DM) + 1e-6f);
#pragma unroll
        for (int i = 0; i < 8; ++i) { const f32x4 y = v[i] * rstd * gv[i];
            if (TO_BF16) { u32x2 w; w.x = cvtpk2(y[0], y[1]); w.y = cvtpk2(y[2], y[3]); *(u32x2*)(ob + (size_t)row * DM + (lane + 64 * i) * 4) = w; }
            else *(f32x4*)(of + (size_t)row * DM + (lane + 64 * i) * 4) = y; }
    }
}

__device__ void xconv_phase(const float* __restrict__ x, bf16_t* __restrict__ ob, float* __restrict__ ssq) {
    const int tid_ = opaque_tid(); const int wid = tid_ >> 6, lane = tid_ & 63;
    for (int row = opaque_bx() * 8 + wid; row < M_TOK; row += opaque_gx() * 8) {
        const float* xr = x + (size_t)row * DM; f32x4 v[8]; float ss = 0.f;
#pragma unroll
        for (int i = 0; i < 8; ++i) v[i] = *(const f32x4*)(xr + (lane + 64 * i) * 4);
#pragma unroll
        for (int i = 0; i < 8; ++i) { ss += v[i][0] * v[i][0] + v[i][1] * v[i][1] + v[i][2] * v[i][2] + v[i][3] * v[i][3];
            u32x2 w; w.x = cvtpk2(v[i][0], v[i][1]); w.y = cvtpk2(v[i][2], v[i][3]); *(u32x2*)(ob + (size_t)row * DM + (lane + 64 * i) * 4) = w; }
#pragma unroll
        for (int o = 32; o >= 1; o >>= 1) ss += __shfl_xor(ss, o);
        if (lane < 32) ssq[(size_t)row * 32 + lane] = lane == 0 ? ss : 0.f;
    }
}

__device__ void im2col_phase(const bf16_t* __restrict__ P, const float* __restrict__ posk, const float* __restrict__ posv, bf16_t* __restrict__ AKV, float* __restrict__ HPRE) {
    const int nth = opaque_gx() * 512;
    for (int i = opaque_bx() * 512 + opaque_tid(); i < 2 * 16 * 128 * 32 * 16; i += nth) {
        const int c8 = i & 15, l = (i >> 4) & 31, n = (i >> 9) & 127, bg = (i >> 16) & 15, kv = i >> 20, b = bg >> 1, g = bg & 1;
        u32x4 w = {0u, 0u, 0u, 0u};
        if (n < 127) {
            const u32x4 s = *(const u32x4*)(P + (size_t)(b * TSEQ + 16 * n + l) * LDP + (kv ? 1280 : 1024) + g * 128 + c8 * 8);
            const float* pp = (kv ? posv : posk) + l * 128 + c8 * 8; const f32x4 p0 = *(const f32x4*)pp, p1 = *(const f32x4*)(pp + 4);
            w.x = cvtpk2(bf_lo(s.x) + p0[0], bf_hi(s.x) + p0[1]); w.y = cvtpk2(bf_lo(s.y) + p0[2], bf_hi(s.y) + p0[3]);
            w.z = cvtpk2(bf_lo(s.z) + p1[0], bf_hi(s.z) + p1[1]); w.w = cvtpk2(bf_lo(s.w) + p1[2], bf_hi(s.w) + p1[3]);
        }
        *(u32x4*)(AKV + (size_t)(kv * 2048 + bg * 128 + n) * 4096 + l * 128 + c8 * 8) = w;
    }
}

__device__ void hconv_phase(const float* __restrict__ HPRE, bf16_t* __restrict__ HC) {
    const int nth = opaque_gx() * 512;
    for (int i = opaque_bx() * 512 + opaque_tid(); i < 2048 * 512 / 8; i += nth) {
        f32x4 a = *(const f32x4*)(HPRE + (size_t)i * 8), b = *(const f32x4*)(HPRE + (size_t)i * 8 + 4); f32x4 x, y;
#pragma unroll
        for (int sl = 1; sl < 8; ++sl) { a += *(const f32x4*)(HPRE + (size_t)sl * (2048 * 512) + (size_t)i * 8); b += *(const f32x4*)(HPRE + (size_t)sl * (2048 * 512) + (size_t)i * 8 + 4); }
#pragma unroll
        for (int j = 0; j < 4; ++j) { x[j] = a[j] * __builtin_amdgcn_rcpf(1.0f + __builtin_amdgcn_exp2f(-1.4426950408889634f * a[j])); y[j] = b[j] * __builtin_amdgcn_rcpf(1.0f + __builtin_amdgcn_exp2f(-1.4426950408889634f * b[j])); }
        u32x4 w; w.x = cvtpk2(x[0], x[1]); w.y = cvtpk2(x[2], x[3]); w.z = cvtpk2(y[0], y[1]); w.w = cvtpk2(y[2], y[3]);
        *(u32x4*)(HC + (size_t)i * 8) = w;
    }
}

__device__ void cmp_mlp_phase(const bf16_t* __restrict__ P, const bf16_t* __restrict__ WC1, const bf16_t* __restrict__ WC2, const float* __restrict__ PT, bf16_t* __restrict__ KC, bf16_t* __restrict__ VCT, unsigned char* lds) {
    const int tid = opaque_tid(), wid = tid >> 6, lane = tid & 63, c = lane & 31, hi = lane >> 5;
    float* red = (float*)lds;
    for (int wgi = opaque_bx(); wgi < 64; wgi += opaque_gx()) {
        const int kv = wgi >> 5, bg = (wgi >> 1) & 15, sp = wgi & 1, b = bg >> 1, g = bg & 1;
        const int srow = tid >> 3, sch = (tid & 7) * 2, sn = sp * 64 + srow; const bool sval = sn < 127;
        const bf16_t* spp = P + (size_t)(b * TSEQ + 16 * (sval ? sn : 0)) * LDP + (kv ? 1280 : 1024) + g * 128 + sch * 8;
        const int sw0 = srow * 256 + ((sch ^ (srow & 15)) << 4), sw1 = srow * 256 + (((sch + 1) ^ (srow & 15)) << 4);
        const int rbase = c * 256, cx = c & 15;
        const bf16_t* w1p = WC1 + (size_t)(kv * 256 + 32 * wid + c) * 4096 + hi * 8;
        { float* ptl = (float*)(lds + 65536); const float* pq = PT + (size_t)kv * 64 * 256 + (size_t)((tid >> 8) * 32) * 256 + (tid & 255); float a = 0.f;
#pragma unroll
          for (int jx = 0; jx < 32; ++jx) a += pq[(size_t)jx * 256];
          ptl[tid] = a; }
        f32x16 h0 = f32x16{}, h1 = f32x16{};
        bf16x8 wA[8], wB[8]; u32x4 sa0 = {0u, 0u, 0u, 0u}, sa1 = {0u, 0u, 0u, 0u};
#define CM_LOADA(l_) do { if (sval) { sa0 = *(const u32x4*)(spp + (size_t)(l_) * LDP); sa1 = *(const u32x4*)(spp + (size_t)(l_) * LDP + 8); } } while (0)
#define CM_LOADW(W_, l_) do { _Pragma("unroll") for (int s8 = 0; s8 < 8; ++s8) W_[s8] = *(const bf16x8*)(w1p + (l_) * 128 + s8 * 16); } while (0)
#define CM_STA(buf_) do { *(u32x4*)(lds + (buf_) * 16384 + sw0) = sa0; *(u32x4*)(lds + (buf_) * 16384 + sw1) = sa1; } while (0)
#define CM_COMPUTE(buf_, W_) do { _Pragma("unroll") for (int s8 = 0; s8 < 8; ++s8) { const int off_ = (((s8 * 2 + hi) ^ cx) << 4); \
            const bf16x8 a0_ = *(const bf16x8*)(lds + (buf_) * 16384 + rbase + off_), a1_ = *(const bf16x8*)(lds + (buf_) * 16384 + 32 * 256 + rbase + off_); \
            h0 = __builtin_amdgcn_mfma_f32_32x32x16_bf16(W_[s8], a0_, h0, 0, 0, 0); h1 = __builtin_amdgcn_mfma_f32_32x32x16_bf16(W_[s8], a1_, h1, 0, 0, 0); } } while (0)
        CM_LOADA(0); CM_LOADW(wA, 0); CM_STA(0);
        __syncthreads();
        for (int l = 0; l < 32; l += 2) {
            CM_LOADA(l + 1); CM_LOADW(wB, l + 1);
            CM_COMPUTE(0, wA);
            CM_STA(1);
            __syncthreads();
            if (l + 2 < 32) { CM_LOADA(l + 2); CM_LOADW(wA, l + 2); }
            CM_COMPUTE(1, wB);
            if (l + 2 < 32) CM_STA(0);
            __syncthreads();
        }
#undef CM_LOADA
#undef CM_LOADW
#undef CM_STA
#undef CM_COMPUTE
        const float* ptp = (const float*)(lds + 65536) + 32 * wid + 4 * hi;
#pragma unroll
        for (int r = 0; r < 16; ++r) { const float pt = ptp[(r & 3) + 8 * (r >> 2)] + ptp[256 + (r & 3) + 8 * (r >> 2)]; float x0 = h0[r] + pt, x1 = h1[r] + pt;
            h0[r] = x0 * __builtin_amdgcn_rcpf(1.0f + __builtin_amdgcn_exp2f(-1.4426950408889634f * x0)); h1[r] = x1 * __builtin_amdgcn_rcpf(1.0f + __builtin_amdgcn_exp2f(-1.4426950408889634f * x1)); }
        bf16x8 pa[2][2];
#define CM_PK4(PV, B_, OUT) do { unsigned a0 = cvtpk2(PV[B_ + 0], PV[B_ + 1]), a1 = cvtpk2(PV[B_ + 2], PV[B_ + 3]), b0 = cvtpk2(PV[B_ + 4], PV[B_ + 5]), b1 = cvtpk2(PV[B_ + 6], PV[B_ + 7]); \
        auto r0 = __builtin_amdgcn_permlane32_swap(a0, b0, false, false); auto r1 = __builtin_amdgcn_permlane32_swap(a1, b1, false, false); \
        u32x4 w_ = {r0[0], r1[0], r0[1], r1[1]}; OUT = *reinterpret_cast<bf16x8*>(&w_); } while (0)
        CM_PK4(h0, 0, pa[0][0]); CM_PK4(h0, 8, pa[0][1]); CM_PK4(h1, 0, pa[1][0]); CM_PK4(h1, 8, pa[1][1]);
#undef CM_PK4
        bf16x8 w2[4][2];
#pragma unroll
        for (int dg = 0; dg < 4; ++dg)
#pragma unroll
            for (int u = 0; u < 2; ++u) w2[dg][u] = *(const bf16x8*)(WC2 + (size_t)(kv * 128 + 32 * dg + c) * 512 + kv * 256 + 32 * wid + 16 * u + 8 * hi);
#pragma unroll
        for (int st = 0; st < 2; ++st) {
#pragma unroll
            for (int dg = 0; dg < 4; ++dg) { f32x16 o = f32x16{};
#pragma unroll
                for (int u = 0; u < 2; ++u) o = kv ? __builtin_amdgcn_mfma_f32_32x32x16_bf16(pa[st][u], w2[dg][u], o, 0, 0, 0) : __builtin_amdgcn_mfma_f32_32x32x16_bf16(w2[dg][u], pa[st][u], o, 0, 0, 0);
#pragma unroll
                for (int r = 0; r < 16; ++r) red[(wid * 64 + dg * 16 + r) * 64 + lane] = o[r]; }
            __syncthreads();
            { const int dg = wid >> 1, rh = (wid & 1) * 8; float sm[8];
#pragma unroll
              for (int r = 0; r < 8; ++r) { float a = 0.f;
#pragma unroll
                  for (int q = 0; q < 8; ++q) a += red[(q * 64 + dg * 16 + rh + r) * 64 + lane];
                  sm[r] = a; }
              const int nb = (2 * sp + st) * 32;
#pragma unroll
              for (int gq = 0; gq < 2; ++gq) { u32x2 w; w.x = cvtpk2(sm[4 * gq], sm[4 * gq + 1]); w.y = cvtpk2(sm[4 * gq + 2], sm[4 * gq + 3]); const int o4 = 8 * ((rh >> 2) + gq) + 4 * hi;
                  if (kv == 0) *(u32x2*)(KC + ((size_t)bg * 128 + nb + c) * 128 + 32 * dg + o4) = w;
                  else *(u32x2*)(VCT + ((size_t)bg * 128 + 32 * dg + c) * 128 + nb + o4) = w; } }
            __syncthreads();
        }
    }
}

__device__ __forceinline__ int crow16(int r, int hi) { return (r & 3) + 8 * (r >> 2) + 4 * hi; }
__device__ void cmp_attn_phase(const bf16_t* __restrict__ P, const bf16_t* __restrict__ KC, const bf16_t* __restrict__ VCT, bf16_t* __restrict__ OCMP, unsigned* __restrict__ SELM, float* limp_all) {
    const int tid = opaque_tid(), wid = tid >> 6, lane = tid & 63, c = lane & 31, hi = lane >> 5;
    float* limp = limp_all + wid * 256;
    constexpr float C2 = 1.4426950408889634f * 0.08838834764831845f;
    const float NEGINF = -__builtin_inff();
    for (int item = opaque_bx() * 8 + wid; item < 4096; item += opaque_gx() * 8) {
        const int bg = item >> 8, tg = (bg & 8) ? 255 - (item & 255) : (item & 255), b = bg >> 1, g = bg & 1, t0 = tg * 8;
        const int tok = c & 7, hr = c >> 3, t = t0 + tok;
        const bf16_t* qp = P + (size_t)(b * TSEQ + t) * LDP + (g * 4 + hr) * 128 + hi * 8;
        bf16x8 qf[8];
#pragma unroll
        for (int ks = 0; ks < 8; ++ks) qf[ks] = *(const bf16x8*)(qp + ks * 16);
        const int nkg = (t0 + 7 >= 31) ? (((t0 + 7 - 31) >> 4) >> 5) + 1 : 0;
        const int nv = (t >= 31) ? ((t - 31) >> 4) : -1;
        const bf16_t* kcb = KC + (size_t)bg * 128 * 128; const bf16_t* vcb = VCT + (size_t)bg * 128 * 128;
        f32x16 s[4];
#pragma unroll
        for (int kg = 0; kg < 4; ++kg) { s[kg] = f32x16{};
            if (kg < nkg) {
#pragma unroll
                for (int ks = 0; ks < 8; ++ks) { const bf16x8 kf = *(const bf16x8*)(kcb + (size_t)(kg * 32 + c) * 128 + ks * 16 + hi * 8); s[kg] = __builtin_amdgcn_mfma_f32_32x32x16_bf16(kf, qf[ks], s[kg], 0, 0, 0); } } }
        float mx = NEGINF;
#pragma unroll
        for (int kg = 0; kg < 4; ++kg)
#pragma unroll
            for (int r = 0; r < 16; ++r) { const int n = kg * 32 + crow16(r, hi); const float x = (n <= nv) ? s[kg][r] * C2 : NEGINF; s[kg][r] = x; mx = fmaxf(mx, x); }
        mx = fmaxf(mx, __shfl_xor(mx, 32));
        if (mx == NEGINF) mx = 0.f;
        float sum = 0.f;
#pragma unroll
        for (int kg = 0; kg < 4; ++kg)
#pragma unroll
            for (int r = 0; r < 16; ++r) { const float e = __builtin_amdgcn_exp2f(s[kg][r] - mx); s[kg][r] = e; sum += e; }
        sum += __shfl_xor(sum, 32);
        const float inv = sum > 0.f ? 1.0f / sum : 0.f;
#pragma unroll
        for (int kg = 0; kg < 4; ++kg)
#pragma unroll
            for (int r = 0; r < 16; ++r) s[kg][r] *= inv;
        float av[16], rv[16];
#pragma unroll
        for (int f = 0; f < 16; ++f) { const int kg = f >> 2, q4 = (f & 3) * 4; const float bb = 0.5f * s[kg][q4 + 3]; av[f] = s[kg][q4] + s[kg][q4 + 1] + s[kg][q4 + 2] + bb; rv[f] = __shfl_xor(bb, 32); }
#pragma unroll
        for (int f = 0; f < 16; ++f) { float im = av[f] + (hi ? rv[f] : (f > 0 ? rv[f > 0 ? f - 1 : 0] : 0.f));
            im += __shfl_xor(im, 8); im += __shfl_xor(im, 16);
            if (c < 8) limp[tok * 32 + 2 * f + hi] = im; }
        bf16x8 pa[8];
#define CMP_PK4(PV, B_, OUT) do { unsigned a0 = cvtpk2(PV[B_ + 0], PV[B_ + 1]), a1 = cvtpk2(PV[B_ + 2], PV[B_ + 3]), b0 = cvtpk2(PV[B_ + 4], PV[B_ + 5]), b1 = cvtpk2(PV[B_ + 6], PV[B_ + 7]); \
        auto r0 = __builtin_amdgcn_permlane32_swap(a0, b0, false, false); auto r1 = __builtin_amdgcn_permlane32_swap(a1, b1, false, false); \
        u32x4 w_ = {r0[0], r1[0], r0[1], r1[1]}; OUT = *reinterpret_cast<bf16x8*>(&w_); } while (0)
#pragma unroll
        for (int kg = 0; kg < 4; ++kg) { CMP_PK4(s[kg], 0, pa[2 * kg]); CMP_PK4(s[kg], 8, pa[2 * kg + 1]); }
#undef CMP_PK4
        bf16_t* ob = OCMP + (size_t)(b * TSEQ + t0) * 1024 + g * 512;
#pragma unroll
        for (int d0 = 0; d0 < 4; ++d0) { f32x16 o = f32x16{};
#pragma unroll
            for (int u = 0; u < 8; ++u) if (u < 2 * nkg) { const bf16x8 vf = *(const bf16x8*)(vcb + (size_t)(d0 * 32 + c) * 128 + u * 16 + hi * 8); o = __builtin_amdgcn_mfma_f32_32x32x16_bf16(pa[u], vf, o, 0, 0, 0); }
#pragma unroll
            for (int r = 0; r < 16; ++r) { const int qrow = crow16(r, hi); const float v = o[r], vn = __shfl_xor(v, 1);
                if ((c & 1) == 0) *(unsigned*)(ob + (size_t)(qrow & 7) * 1024 + (qrow >> 3) * 128 + d0 * 32 + c) = cvtpk2(v, vn); } }
        asm volatile("s_waitcnt lgkmcnt(0)" ::: "memory");
        const int tk = lane & 7, sb = lane >> 3, tt = t0 + tk, cur = tt >> 6;
        unsigned mask;
        if (t0 < 1024) mask = (2u << cur) - 1u;
        else {
            float v[32];
#pragma unroll
            for (int sI = 0; sI < 32; ++sI) { float x = limp[tk * 32 + sI]; const bool forced = (sI == 0) | (sI == cur) | (sI == cur - 1); x = forced ? 1e4f : x; v[sI] = (sI <= cur) ? x : -1.f; }
            mask = 0u;
#pragma unroll
            for (int jx = 0; jx < 4; ++jx) { const int sI = sb * 4 + jx;
                float mine = v[0];
#pragma unroll
                for (int s2 = 1; s2 < 32; ++s2) mine = (s2 == sI) ? v[s2] : mine;
                int rank = 0;
#pragma unroll
                for (int s2 = 0; s2 < 32; ++s2) rank += (v[s2] > mine || (v[s2] == mine && s2 < sI)) ? 1 : 0;
                if (rank < 16 && mine >= 0.f) mask |= 1u << sI; }
            mask |= __shfl_xor(mask, 8); mask |= __shfl_xor(mask, 16); mask |= __shfl_xor(mask, 32);
        }
        if (lane < 8) SELM[bg * TSEQ + tt] = mask;
        asm volatile("s_waitcnt lgkmcnt(0)" ::: "memory");
    }
}

typedef att::BlockRef<att::bf16, att::bf16> ABlk;
__device__ void attn_build_items(int* items) {
    for (int i = opaque_bx() * 512 + opaque_tid(); i < 2048; i += opaque_gx() * 512) {
        int kind, j, qb;
        if (i < 960) { qb = 7 - i / 192; j = i % 192; kind = 0; }
        else if (i < 1536) { j = i - 960; if (j < 192) { kind = 0; qb = 2; } else { kind = 1; j -= 192; qb = 2 + (j >> 6); j &= 63; } }
        else if (i < 1792) { j = i - 1536; qb = 1; if (j < 192) kind = 0; else { kind = 1; j -= 192; } }
        else { j = i - 1792; qb = 0; if (j < 192) kind = 0; else { kind = 1; j -= 192; } }
        int b, qcol, kcol, vcol, ocol; size_t obuf; unsigned so = 0xffffffffu; int W = 1 << 20;
        if (kind == 1) { b = j >> 3; const int h = j & 7; qcol = h * 128; kcol = 2048 + (h >> 2) * 128; vcol = 2304 + (h >> 2) * 128; obuf = WS_OWIN; ocol = h * 128; W = 512; }
        else if (j >= 128) { j -= 128; b = j >> 3; const int h = j & 7; qcol = h * 128; kcol = 1536 + (h >> 2) * 128; vcol = 1792 + (h >> 2) * 128; obuf = WS_OSLC; ocol = h * 128;
            so = (unsigned)(WS_SELM + ((size_t)(b * 2 + (h >> 2)) * TSEQ + qb * 256) * 4); }
        else { b = j >> 4; const int hd = (j >> 2) & 3, cc = (j >> 1) & 1, vh = j & 1; qcol = 2560 + (hd * 2 + cc) * 128; kcol = 3584 + (hd * 2 + cc) * 128; vcol = 4608 + hd * 256 + vh * 128;
            obuf = cc ? WS_OD2 : WS_OD1; ocol = hd * 256 + vh * 128; }
        int* it = items + i * 8;
        it[0] = (int)(unsigned)(WS_ACT + ((size_t)(b * TSEQ + qb * 256) * LDP + qcol) * 2); it[1] = (int)(unsigned)(WS_ACT + ((size_t)(b * TSEQ) * LDP + kcol) * 2);
        it[2] = (int)(unsigned)(WS_ACT + ((size_t)(b * TSEQ) * LDP + vcol) * 2); it[3] = (int)(unsigned)(obuf + ((size_t)(b * TSEQ + qb * 256) * 1024 + ocol) * 2);
        it[4] = (int)so; it[5] = qb * 256; it[6] = W; it[7] = 0;
    }
}
__device__ __forceinline__ ABlk attn_item(const char* ws, const int* items, int i) {
    const int4 a = *(const int4*)(items + i * 8), b = *(const int4*)(items + i * 8 + 4);
    ABlk r; r.base = ws;
    r.qo = (unsigned)__builtin_amdgcn_readfirstlane(a.x); r.ko = (unsigned)__builtin_amdgcn_readfirstlane(a.y); r.vo = (unsigned)__builtin_amdgcn_readfirstlane(a.z); r.oo = (unsigned)__builtin_amdgcn_readfirstlane(a.w);
    r.so = (unsigned)__builtin_amdgcn_readfirstlane(b.x); r.P0 = __builtin_amdgcn_readfirstlane(b.y); r.W = __builtin_amdgcn_readfirstlane(b.z);
    return r;
}
__device__ void attn_phase(const char* ws, const int* items, char* lds) {
    const int G = opaque_gx(), wb = opaque_bx();
    const int w = (G == 256) ? (((wb & 7) << 2) | ((wb >> 3) & 3) | ((wb >> 5) << 5)) : wb;
    int rnd = 0;
    if (w >= 2048) return;
    ABlk cur = attn_item(ws, items, w);
    att::Seam<att::bf16> S;
    att::causal_swa_prime<att::bf16, att::bf16>(cur, lds, S);
    for (;;) {
        const int rn = rnd + 1; const int sn = rn * G + ((rn & 1) ? G - 1 - w : w); const bool more = sn < 2048;
        const ABlk nxt = more ? attn_item(ws, items, sn) : cur;
        att::causal_swa_block<att::bf16, att::bf16>(cur, nxt, TSEQ, lds, S);
        if (!more) break;
        cur = nxt; rnd = rn;
    }
}

__device__ __forceinline__ void ld16bf(const bf16_t* p, float (&o)[16]) { const u32x4 a = *(const u32x4*)p, b = *(const u32x4*)(p + 8);
    o[0] = bf_lo(a.x); o[1] = bf_hi(a.x); o[2] = bf_lo(a.y); o[3] = bf_hi(a.y); o[4] = bf_lo(a.z); o[5] = bf_hi(a.z); o[6] = bf_lo(a.w); o[7] = bf_hi(a.w);
    o[8] = bf_lo(b.x); o[9] = bf_hi(b.x); o[10] = bf_lo(b.y); o[11] = bf_hi(b.y); o[12] = bf_lo(b.z); o[13] = bf_hi(b.z); o[14] = bf_lo(b.w); o[15] = bf_hi(b.w); }
__device__ __forceinline__ void st16bf(bf16_t* p, const float (&v)[16]) { u32x4 a, b; a.x = cvtpk2(v[0], v[1]); a.y = cvtpk2(v[2], v[3]); a.z = cvtpk2(v[4], v[5]); a.w = cvtpk2(v[6], v[7]);
    b.x = cvtpk2(v[8], v[9]); b.y = cvtpk2(v[10], v[11]); b.z = cvtpk2(v[12], v[13]); b.w = cvtpk2(v[14], v[15]); *(u32x4*)p = a; *(u32x4*)(p + 8) = b; }
__device__ void combine_phase(KParamsPtr pp_, int l, const float* __restrict__ gates, const bf16_t* OCMP, const bf16_t* OSLC, const bf16_t* OWIN, const bf16_t* OD1, const bf16_t* OD2, bf16_t* HB) {
    const int tid_ = opaque_tid(); const int wid = tid_ >> 6, lane = tid_ & 63;
    const float* q1 = pp_->in[13] + l * 128; const float* k1 = pp_->in[14] + l * 128; const float* q2 = pp_->in[15] + l * 128; const float* k2 = pp_->in[16] + l * 128;
    float s1 = q1[lane] * k1[lane] + q1[lane + 64] * k1[lane + 64], s2 = q2[lane] * k2[lane] + q2[lane + 64] * k2[lane + 64];
#pragma unroll
    for (int o = 32; o >= 1; o >>= 1) { s1 += __shfl_xor(s1, o); s2 += __shfl_xor(s2, o); }
    const float lam_init = l == 0 ? 0.2f : 0.35550906759096926f;
    const float lam = expf(s1) - expf(s2) + lam_init;
    float sg[16]; { const float* sp = pp_->in[17] + l * 256 + (lane & 15) * 16;
#pragma unroll
        for (int j = 0; j < 16; ++j) sg[j] = sp[j] * (1.0f - lam_init); }
    for (int row = opaque_bx() * 8 + wid; row < M_TOK; row += opaque_gx() * 8) {
        { const int head = lane >> 3; const float* gp = gates + (size_t)row * 32 + head * 3; const float g0 = gp[0], g1 = gp[1], g2 = gp[2];
          float a[16], bq[16], cq[16]; const size_t off = (size_t)row * 1024 + lane * 16;
          ld16bf(OCMP + off, a); ld16bf(OSLC + off, bq); ld16bf(OWIN + off, cq);
#pragma unroll
          for (int j = 0; j < 16; ++j) a[j] = g0 * a[j] + g1 * bq[j] + g2 * cq[j];
          st16bf(HB + (size_t)row * DM + lane * 16, a); }
        { float a[16], bq[16]; const size_t off = (size_t)row * 1024 + lane * 16;
          ld16bf(OD1 + off, a); ld16bf(OD2 + off, bq); float ss = 0.f;
#pragma unroll
          for (int j = 0; j < 16; ++j) { a[j] = a[j] - lam * bq[j]; ss += a[j] * a[j]; }
          ss += __shfl_xor(ss, 1); ss += __shfl_xor(ss, 2); ss += __shfl_xor(ss, 4); ss += __shfl_xor(ss, 8);
          const float rstd = 1.0f / sqrtf(ss * (1.0f / 256.0f) + 1e-6f);
#pragma unroll
          for (int j = 0; j < 16; ++j) a[j] = a[j] * rstd * sg[j];
          st16bf(HB + (size_t)row * DM + 1024 + lane * 16, a); }
    }
}

__device__ void rstd_table(const float* __restrict__ ssq, PG8_LAS float* tab) {
    const int tid = opaque_tid(), bx = opaque_bx(), pm = 8 * (bx & 7) + ((bx >> 3) & 7);
    if (tid < 256) { const int row = pm * 256 + tid; const float* p = ssq + (size_t)row * 32; float sm = 0.f;
#pragma unroll
        for (int c4 = 0; c4 < 8; ++c4) { const f32x4 a = *(const f32x4*)(p + 4 * c4); sm += (a[0] + a[1]) + (a[2] + a[3]); }
        tab[row & 2047] = 1.0f / sqrtf(sm * (1.0f / 2048.0f) + 1e-6f); }
    __syncthreads();
}

#define XB_LAS __attribute__((address_space(3)))
#define XB_TMO      128
#define XB_XCNT(j)  (256  + 64 * (j))
#define XB_XSUB(j)  (1280 + 64 * (j))
#define XB_XGEN(j)  (2304 + 64 * (j))
#define XB_TOP      3328
#define XB_TOPGEN   3392
#define XCD_BAR_WORDS 3456
#define XB_SPIN_CAP (1u << 18)

__device__ __forceinline__ unsigned xb_ld(unsigned* p)              { return __hip_atomic_load(p, __ATOMIC_RELAXED, __HIP_MEMORY_SCOPE_AGENT); }
__device__ __forceinline__ unsigned xb_add(unsigned* p, unsigned v) { return __hip_atomic_fetch_add(p, v, __ATOMIC_RELAXED, __HIP_MEMORY_SCOPE_AGENT); }
__device__ __forceinline__ unsigned xb_xcc_id() { return (unsigned)__builtin_amdgcn_s_getreg((3 << 11) | 20) & 0xFu; }
#define XB_SPIN(cond, bar) do { unsigned _sp = 0; while (cond) { __builtin_amdgcn_s_sleep(1); \
    if ((++_sp & 255u) == 0u) { if (xb_ld(&(bar)[XB_TMO])) break; if (_sp > XB_SPIN_CAP) { atomicAdd(&(bar)[XB_TMO], 1u); break; } } } } while (0)

struct XcdBarrier {
    unsigned* bar; unsigned x;
    volatile XB_LAS unsigned* st;
};

__device__ __forceinline__ XcdBarrier xcd_barrier_post(unsigned* bar, volatile XB_LAS unsigned* st) {
    XcdBarrier b; b.bar = bar; b.x = xb_xcc_id(); b.st = st;
    if (threadIdx.x == 0) (void)xb_add(&bar[XB_XCNT(b.x)], 1u);
    return b;
}
__device__ __forceinline__ void xcd_barrier_complete(unsigned* bar, unsigned x, unsigned& nloc, unsigned& nx) {
    const unsigned G = gridDim.x * gridDim.y * gridDim.z;
    unsigned sum, cnt, mine, sp = 0u;
    for (;;) {
        sum = 0u; cnt = 0u; mine = 0u;
#pragma unroll
        for (unsigned j = 0; j < 16; ++j) { const unsigned c = xb_ld(&bar[XB_XCNT(j)]); sum += c; cnt += (c > 0u) ? 1u : 0u; mine = (j == x) ? c : mine; }
        if (sum == G) break;
        __builtin_amdgcn_s_sleep(1);
        if ((++sp & 255u) == 0u) { if (xb_ld(&bar[XB_TMO])) break; if (sp > XB_SPIN_CAP) { atomicAdd(&bar[XB_TMO], 1u); break; } }
    }
    nloc = mine > 0u ? mine : 1u; nx = cnt > 0u ? cnt : 1u;
}

__device__ __forceinline__ void xcd_barrier(const XcdBarrier& b) {
    asm volatile("s_waitcnt vmcnt(0)" ::: "memory");
    __syncthreads();
    if (threadIdx.x == 0) {
        unsigned* bar = b.bar; unsigned bx_ = b.x; asm volatile("" : "+s"(bar), "+s"(bx_));
        __builtin_amdgcn_s_waitcnt(0);
        unsigned nloc = b.st[0], nx = b.st[1];
        if (nloc == 0u) { xcd_barrier_complete(bar, bx_, nloc, nx); b.st[0] = nloc; b.st[1] = nx; }
        const unsigned old = xb_add(&bar[XB_XSUB(bx_)], 1u);
        const unsigned gen = old / nloc;
        if (old + 1u == (gen + 1u) * nloc) {
            __builtin_amdgcn_fence(__ATOMIC_RELEASE, "agent");
            asm volatile("s_waitcnt vmcnt(0)" ::: "memory");
            const unsigned og = xb_add(&bar[XB_TOP], 1u);
            const unsigned tg = og / nx;
            if (og + 1u == (tg + 1u) * nx) xb_add(&bar[XB_TOPGEN], 1u);
            else XB_SPIN(xb_ld(&bar[XB_TOPGEN]) == tg, bar);
            __builtin_amdgcn_fence(__ATOMIC_ACQUIRE, "agent");
            xb_add(&bar[XB_XGEN(bx_)], 1u);
            asm volatile("s_waitcnt vmcnt(0)" ::: "memory");
        } else {
            XB_SPIN(xb_ld(&bar[XB_XGEN(bx_)]) == gen, bar);
            __builtin_amdgcn_fence(__ATOMIC_ACQUIRE, "agent");
            asm volatile("s_waitcnt vmcnt(0)" ::: "memory");
        }
    }
    __syncthreads();
}

constexpr int LDS_TOTAL = pg8::STAGE_BYTES + 64 + 8192;
__device__ __forceinline__ KParamsPtr kparams() { KParamsPtr q = (KParamsPtr)__builtin_amdgcn_kernarg_segment_ptr(); asm volatile("" : "+s"(q)); return q; }
#define WSP(T, off) ((T*)(pp->ws + (off)))
#define HBP ((bf16_t*)pp->out)
#define OCMPP ((bf16_t*)((char*)pp->out + (size_t)M_TOK * DM * 2))
#define HPREP ((float*)((char*)pp->out + (size_t)M_TOK * DM * 2 + SZ_O))
__global__ void __launch_bounds__(512) mega_fwd(Params p_unused) {
    extern __shared__ __attribute__((aligned(16))) unsigned char lds[];
    cg::grid_group grid = cg::this_grid();
    PG8_LAS unsigned char* glds = (PG8_LAS unsigned char*)lds; PG8_LAS float* rtab = (PG8_LAS float*)(glds + pg8::STAGE_BYTES + 64);
    if (threadIdx.x < 4) ((volatile XB_LAS unsigned*)(lds + pg8::STAGE_BYTES))[threadIdx.x] = 0u;
    __syncthreads();
    XcdBarrier xbar; { KParamsPtr pp = kparams(); xbar = xcd_barrier_post(WSP(unsigned, WS_BAR), (volatile XB_LAS unsigned*)(lds + pg8::STAGE_BYTES)); }
    { KParamsPtr pp = kparams(); prep_phase(pp, (float*)lds); attn_build_items(WSP(int, WS_ITEMS));
      xconv_phase(pp->in[0], HBP, WSP(float, WS_SSQ));
      if (pp->ws == nullptr) grid.sync(); }
    xcd_barrier(xbar);
    for (int ph = 0; ph < 20; ++ph) {
        const int l = ph >= 10 ? 1 : 0, q = ph - 10 * l;
        const bool first = (ph <= 1);
        if (q == 0 || q == 8) {
            KParamsPtr pp = kparams(); unsigned char* wl = pp->ws + (size_t)l * SZ_LAYER;
            rstd_table(WSP(const float, WS_SSQ), rtab);
            pg8::Gemm g{ph == 0 ? HBP : WSP(bf16_t, WS_XR), (const bf16_t*)(wl + (q == 0 ? OFF_W1A : OFF_W2A)), M_TOK, 2 * DFF, DM}; pg8::StaticOrder S; S.init(M_TOK, 2 * DFF, opaque_gx(), opaque_bx());
            pg8::EpiSwiGLU E{WSP(bf16_t, WS_ACT), DFF, rtab}; pg8::gemm_phase<pg8::EpiSwiGLU, pg8::StaticOrder>(glds, g, S, E, nullptr);
        } else if (q == 1 || q == 7 || q == 9) {
            KParamsPtr pp = kparams(); unsigned char* wl = pp->ws + (size_t)l * SZ_LAYER;
            pg8::Gemm gr; float rscale;
            if (q == 1) { gr = pg8::Gemm{WSP(bf16_t, WS_ACT), (const bf16_t*)(wl + OFF_W1D), M_TOK, DM, DFF}; rscale = 0.5f; }
            else if (q == 7) { gr = pg8::Gemm{HBP, (const bf16_t*)(wl + OFF_WOUT), M_TOK, DM, DM}; rscale = 1.0f; }
            else { gr = pg8::Gemm{WSP(bf16_t, WS_ACT), (const bf16_t*)(wl + OFF_W2D), M_TOK, DM, DFF}; rscale = 0.5f; }
            pg8::StaticOrder S; S.init(M_TOK, DM, opaque_gx(), opaque_bx()); pg8::EpiRes E{first ? pp->in[0] : (const float*)nullptr, WSP(bf16_t, WS_XR), DM, rscale, WSP(float, WS_SSQ)};
            pg8::gemm_phase<pg8::EpiRes, pg8::StaticOrder>(glds, gr, S, E, nullptr);
        } else if (q == 2) {
            KParamsPtr pp = kparams(); unsigned char* wl = pp->ws + (size_t)l * SZ_LAYER;
            rstd_table(WSP(const float, WS_SSQ), rtab);
            pg8::Gemm g{WSP(bf16_t, WS_XR), (const bf16_t*)(wl + OFF_WIN), M_TOK, NPROJ, DM}; pg8::StaticOrder S; S.init(M_TOK, NPROJ, opaque_gx(), opaque_bx());
            pg8::EpiProj E{WSP(bf16_t, WS_ACT), WSP(float, WS_GATES), WSP(const float, WS_ROPEC), WSP(const float, WS_ROPES), rtab}; pg8::gemm_phase<pg8::EpiProj, pg8::StaticOrder>(glds, g, S, E, nullptr);
        } else if (q == 3) {
            KParamsPtr pp = kparams(); unsigned char* wl = pp->ws + (size_t)l * SZ_LAYER;
            cmp_mlp_phase(WSP(const bf16_t, WS_ACT), (const bf16_t*)(wl + OFF_WC1), (const bf16_t*)(wl + OFF_WC2), WSP(const float, WS_PT) + (size_t)l * 2 * 64 * 256, WSP(bf16_t, WS_KC), WSP(bf16_t, WS_VCT), lds);
        } else if (q == 4) {
            KParamsPtr pp = kparams(); cmp_attn_phase(WSP(const bf16_t, WS_ACT), WSP(const bf16_t, WS_KC), WSP(const bf16_t, WS_VCT), OCMPP, WSP(unsigned, WS_SELM), (float*)lds);
        } else if (q == 5) {
            KParamsPtr pp = kparams(); attn_phase((const char*)pp->ws, WSP(const int, WS_ITEMS), (char*)lds);
        } else {
            KParamsPtr pp = kparams(); combine_phase(pp, l, WSP(const float, WS_GATES), (const bf16_t*)OCMPP, WSP(const bf16_t, WS_OSLC), WSP(const bf16_t, WS_OWIN), WSP(const bf16_t, WS_OD1), WSP(const bf16_t, WS_OD2), HBP);
        }
        xcd_barrier(xbar);
    }
    { KParamsPtr pp = kparams(); rmsnorm_phase<true, false>(WSP(const bf16_t, WS_XR), pp->in[23], nullptr, pp->out); }
}

extern "C" void kernel_launch(void* const* d_in, const int* in_sizes, int n_in, void* d_out, int out_size, void* d_ws, size_t ws_size, hipStream_t stream) {
    static int grid = 0;
    if (grid == 0) {
        if (n_in != 24 || in_sizes[0] != M_TOK * DM || out_size != M_TOK * DM || ws_size < WS_END) {
            fprintf(stderr, "kernel_launch: unexpected shapes (n_in %d, in0 %d, out %d, ws %zu need %zu)\n", n_in, n_in > 0 ? in_sizes[0] : -1, out_size, ws_size, (size_t)WS_END); grid = -1; return; }
        int dev = 0, cus = 0, per_cu = 0;
        (void)hipGetDevice(&dev); (void)hipDeviceGetAttribute(&cus, hipDeviceAttributeMultiprocessorCount, dev);
        if (hipFuncSetAttribute((const void*)mega_fwd, hipFuncAttributeMaxDynamicSharedMemorySize, LDS_TOTAL) != hipSuccess) { fprintf(stderr, "kernel_launch: hipFuncSetAttribute failed\n"); grid = -1; return; }
        if (hipOccupancyMaxActiveBlocksPerMultiprocessor(&per_cu, (const void*)mega_fwd, 512, LDS_TOTAL) != hipSuccess || per_cu < 1) { fprintf(stderr, "kernel_launch: occupancy query gave %d\n", per_cu); per_cu = 1; }
        (void)hipGetLastError();
        if (cus <= 0) cus = 256;
        grid = cus;
    }
    if (grid < 0) return;
    if (hipMemsetAsync((char*)d_ws + WS_BAR, 0, 16384, stream) != hipSuccess) { fprintf(stderr, "kernel_launch: memset of barrier words failed\n"); return; }
    Params p{};
    for (int i = 0; i < 24; ++i) p.in[i] = (const float*)d_in[i];
    p.out = (float*)d_out; p.ws = (unsigned char*)d_ws;
    void* args[] = {&p};
    hipError_t e = hipLaunchCooperativeKernel((const void*)mega_fwd, dim3(grid), dim3(512), args, LDS_TOTAL, stream);
    if (e != hipSuccess) fprintf(stderr, "kernel_launch: cooperative launch failed: %s (grid %d)\n", hipGetErrorString(e), grid);
}
```

```cpp
#include <hip/hip_runtime.h>
#include <hip/hip_bf16.h>
#include <hip/hip_cooperative_groups.h>
#include <cstdio>
#include <cstdint>
namespace cg = cooperative_groups;
#define PROBE_SYNC 0
#define PROBE_ATT 0
#define PROBE_PREP 0
#define PROBE_CMP 0
#define PROBE_NORM 0
#define PROBE_HOT 0
#define PROBE_EPI 0
#define PROBE_UP 0
#define PROBE_DOWN 0
__device__ __forceinline__ int opaque_bx() { int b = blockIdx.x; asm volatile("" : "+s"(b)); return b; }
__device__ __forceinline__ int opaque_gx() { int g = gridDim.x; asm volatile("" : "+s"(g)); return g; }
__device__ __forceinline__ int opaque_tid() { int t = threadIdx.x; asm volatile("" : "+v"(t)); return t; }

constexpr int M_TOK = 16384, DM = 2048, DFF = 5632, LDP = 5632, NPROJ = 5888, TSEQ = 2048;
__host__ __device__ constexpr bool is_rope_tile(int pn) { return pn <= 4 || pn == 6 || pn == 8 || (pn >= 10 && pn < 18); }

namespace pg8 {
#define PG8_LAS __attribute__((address_space(3)))
typedef unsigned short bf16_t;
typedef short bf16x8 __attribute__((ext_vector_type(8)));
typedef float f32x4 __attribute__((ext_vector_type(4)));
typedef unsigned u32x4 __attribute__((ext_vector_type(4)));
constexpr int BM = 256, BK = 64, HALF = 128, HTB = HALF * BK * 2  , STAGE_BYTES = 8 * HTB, NXCD = 8, WGM = 8;

__host__ __device__ __forceinline__ int lds_byte(int r, int c) { const int st = (r >> 4) * 2 + (c >> 5), rr = r & 15, cc = c & 31, ob = rr * 64 + cc * 2; return st * 1024 + (ob ^ (((ob >> 9) & 1) << 5)); }
__host__ __device__ __forceinline__ void stage_rc(int b, int& R, int& C) { const int st = b / 1024, sb = b % 1024, swz = sb ^ (((sb >> 9) & 1) << 5); R = (st >> 1) * 16 + swz / 64; C = (st & 1) * 32 + (swz % 64) / 2; }
__host__ __device__ __forceinline__ int perm32(int rho) { const int n = rho >> 4, i = rho & 15; return 8 * (i >> 2) + 4 * n + (i & 3); }

struct Unit { int pm, pn, ko = 0; };
struct Gemm { const bf16_t* A; const bf16_t* Bt; int M, N, K, Kl; };

struct StaticOrder {
    int nM, nN, nwg, G, c;
    __host__ __device__ void init(int M, int N, int G_, int c_) { nM = M / BM; nN = N / BM; nwg = nM * nN; G = G_; c = c_; }
    __host__ __device__ bool next(int i, Unit& u) const {
        const long L = (long)i * G + c; if (L >= nwg) return false;
        int wgid = (int)L; { const int q = nwg / NXCD, r = nwg % NXCD, xcd = wgid % NXCD, off = wgid / NXCD; wgid = (xcd < r ? xcd * (q + 1) : r * (q + 1) + (xcd - r) * q) + off; }
        const int nig = WGM * nN, gid = wgid / nig, fm = gid * WGM, gsz = (nM - fm) < WGM ? (nM - fm) : WGM;
        u.pm = fm + ((wgid % nig) % gsz); u.pn = (wgid % nig) / gsz; return true;
    }
    __device__ __forceinline__ void a_ready(const Unit&) const {}
    __device__ __forceinline__ void done(const Unit&) const {}
};
__device__ __forceinline__ unsigned cvt_pk_bf16(float lo, float hi) { unsigned r; asm volatile("v_cvt_pk_bf16_f32 %0, %1, %2" : "=v"(r) : "v"(lo), "v"(hi)); return r; }
typedef float f32x2 __attribute__((ext_vector_type(2)));
__device__ __forceinline__ float silu_f(float x) { return x * __builtin_amdgcn_rcpf(1.0f + __builtin_amdgcn_exp2f(-1.4426950408889634f * x)); }
__device__ __forceinline__ float sigmoid_f(float x) { return __builtin_amdgcn_rcpf(1.0f + __builtin_amdgcn_exp2f(-1.4426950408889634f * x)); }
__device__ __forceinline__ u32x4 pack8_bf16(f32x4 a, f32x4 b) { u32x4 w; w.x = cvt_pk_bf16(a[0], a[1]); w.y = cvt_pk_bf16(a[2], a[3]); w.z = cvt_pk_bf16(b[0], b[1]); w.w = cvt_pk_bf16(b[2], b[3]); return w; }

__device__ __forceinline__ void load_rstd(const PG8_LAS float* tab, int row0, float (&rs)[2][4]) {
#pragma unroll
    for (int ai = 0; ai < 2; ++ai)
#pragma unroll
        for (int m = 0; m < 4; ++m) rs[ai][m] = tab[(row0 + ai * HALF + m * 16) & 2047];
}
struct EpiSwiGLU {
    static constexpr bool PERM = true, AFTER_DRAIN = false;
    bf16_t* O; int ldc; const PG8_LAS float* rtab;
    __device__ __forceinline__ void operator()(const f32x4 (&acc)[2][2][4][2], const Unit& u, int wr, int wc, int fr, int fq) const {
        const int row0 = u.pm * BM + wr * 64 + fr, col0 = u.pn * 128 + wc * 32 + 8 * fq;
        float rs[2][4]; load_rstd(rtab, row0, rs);
        for (int rep_ = 0; rep_ < 1 + PROBE_EPI; ++rep_)
#pragma unroll
        for (int ai = 0; ai < 2; ++ai)
#pragma unroll
            for (int m = 0; m < 4; ++m) {
                asm volatile("" ::: "memory");
                bf16_t* rowp = O + (size_t)(row0 + ai * HALF + m * 16) * ldc + col0;
                f32x4 v0, v1;
#pragma unroll
                for (int j = 0; j < 4; ++j) { const float r_ = rs[ai][m]; v0[j] = silu_f(acc[ai][0][m][0][j] * r_) * (acc[ai][1][m][0][j] * r_); v1[j] = silu_f(acc[ai][0][m][1][j] * r_) * (acc[ai][1][m][1][j] * r_); }
                *(u32x4*)rowp = pack8_bf16(v0, v1);
            }
    }
};
struct EpiRes {
    static constexpr bool PERM = true, AFTER_DRAIN = false;
    const float* base32; bf16_t* xr; int ldc; float scale; float* ssq;
    __device__ __forceinline__ void operator()(const f32x4 (&acc)[2][2][4][2], const Unit& u, int wr, int wc, int fr, int fq) const {
        const int row0 = u.pm * BM + wr * 64 + fr, col0 = u.pn * BM + wc * 32 + 8 * fq;
        if (base32) {
#pragma unroll
            for (int ai = 0; ai < 2; ++ai) {
                f32x4 bv[4][2][2];
#pragma unroll
                for (int m = 0; m < 4; ++m) { const size_t off = (size_t)(row0 + ai * HALF + m * 16) * ldc + col0;
#pragma unroll
                    for (int bj = 0; bj < 2; ++bj)
#pragma unroll
                        for (int n = 0; n < 2; ++n) bv[m][bj][n] = *(const f32x4*)(base32 + off + bj * HALF + n * 4); }
#pragma unroll
                for (int m = 0; m < 4; ++m) { const size_t off = (size_t)(row0 + ai * HALF + m * 16) * ldc + col0; float ss = 0.f;
#pragma unroll
                    for (int bj = 0; bj < 2; ++bj) { const f32x4 x0 = bv[m][bj][0] + acc[ai][bj][m][0] * scale, x1 = bv[m][bj][1] + acc[ai][bj][m][1] * scale; *(u32x4*)(xr + off + bj * HALF) = pack8_bf16(x0, x1);
                        ss += ((x0[0] * x0[0] + x0[1] * x0[1]) + (x0[2] * x0[2] + x0[3] * x0[3])) + ((x1[0] * x1[0] + x1[1] * x1[1]) + (x1[2] * x1[2] + x1[3] * x1[3])); }
                    ss += __shfl_xor(ss, 16); ss += __shfl_xor(ss, 32); if (fq == 0) ssq[(size_t)(row0 + ai * HALF + m * 16) * 32 + u.pn * 4 + wc] = ss; }
                asm volatile("" ::: "memory");
            }
        } else {
            u32x4 bb[2][4][2];
#pragma unroll
            for (int ai = 0; ai < 2; ++ai)
#pragma unroll
                for (int m = 0; m < 4; ++m) { const size_t off = (size_t)(row0 + ai * HALF + m * 16) * ldc + col0;
#pragma unroll
                    for (int bj = 0; bj < 2; ++bj) bb[ai][m][bj] = *(const u32x4*)(xr + off + bj * HALF); }
#pragma unroll
            for (int ai = 0; ai < 2; ++ai)
#pragma unroll
                for (int m = 0; m < 4; ++m) { const size_t off = (size_t)(row0 + ai * HALF + m * 16) * ldc + col0; float ss = 0.f;
#pragma unroll
                    for (int bj = 0; bj < 2; ++bj) { const u32x4 w = bb[ai][m][bj];
                        const f32x4 b0 = {__uint_as_float(w.x << 16), __uint_as_float(w.x & 0xffff0000u), __uint_as_float(w.y << 16), __uint_as_float(w.y & 0xffff0000u)};
                        const f32x4 b1 = {__uint_as_float(w.z << 16), __uint_as_float(w.z & 0xffff0000u), __uint_as_float(w.w << 16), __uint_as_float(w.w & 0xffff0000u)};
                        const f32x4 x0 = b0 + acc[ai][bj][m][0] * scale, x1 = b1 + acc[ai][bj][m][1] * scale; *(u32x4*)(xr + off + bj * HALF) = pack8_bf16(x0, x1);
                        ss += ((x0[0] * x0[0] + x0[1] * x0[1]) + (x0[2] * x0[2] + x0[3] * x0[3])) + ((x1[0] * x1[0] + x1[1] * x1[1]) + (x1[2] * x1[2] + x1[3] * x1[3])); }
                    ss += __shfl_xor(ss, 16); ss += __shfl_xor(ss, 32); if (fq == 0) ssq[(size_t)(row0 + ai * HALF + m * 16) * 32 + u.pn * 4 + wc] = ss; }
        }
    }
};
struct EpiProj {
    static constexpr bool PERM = true, AFTER_DRAIN = false;
    bf16_t* P; float* gates; const float* rc; const float* rs; const PG8_LAS float* rtab;
    __device__ __forceinline__ void operator()(const f32x4 (&acc_)[2][2][4][2], const Unit& u, int wr, int wc, int fr, int fq) const {
        const int row0 = u.pm * BM + wr * 64 + fr, pn = u.pn;
        float rsd[2][4]; load_rstd(rtab, row0, rsd);
        f32x4 acc[2][2][4][2];
#pragma unroll
        for (int ai = 0; ai < 2; ++ai)
#pragma unroll
            for (int bj = 0; bj < 2; ++bj)
#pragma unroll
                for (int m = 0; m < 4; ++m)
#pragma unroll
                    for (int n = 0; n < 2; ++n) acc[ai][bj][m][n] = acc_[ai][bj][m][n] * rsd[ai][m];
        if (pn == 22) {
            if (wc == 0 && fq < 3) {
#pragma unroll
                for (int ai = 0; ai < 2; ++ai)
#pragma unroll
                    for (int m = 0; m < 4; ++m) { float* gp = gates + (size_t)(row0 + ai * HALF + m * 16) * 32 + 8 * fq;
#pragma unroll
                        for (int n = 0; n < 2; ++n) { f32x4 v;
#pragma unroll
                            for (int j = 0; j < 4; ++j) v[j] = sigmoid_f(acc[ai][0][m][n][j]);
                            *(f32x4*)(gp + 4 * n) = v; } }
            }
        } else if (is_rope_tile(pn)) {
            const int hp = wc >> 1, d0 = 32 * (wc & 1) + 8 * fq;
#pragma unroll
            for (int ai = 0; ai < 2; ++ai)
#pragma unroll
                for (int m = 0; m < 4; ++m) { const int row = row0 + ai * HALF + m * 16, t = row & (TSEQ - 1);
                    const f32x4 c0 = *(const f32x4*)(rc + t * 64 + d0), c1 = *(const f32x4*)(rc + t * 64 + d0 + 4), s0 = *(const f32x4*)(rs + t * 64 + d0), s1 = *(const f32x4*)(rs + t * 64 + d0 + 4);
                    const f32x4 x1a = acc[ai][0][m][0], x1b = acc[ai][0][m][1], x2a = acc[ai][1][m][0], x2b = acc[ai][1][m][1];
                    const f32x4 o1a = x1a * c0 - x2a * s0, o1b = x1b * c1 - x2b * s1, o2a = x2a * c0 + x1a * s0, o2b = x2b * c1 + x1b * s1;
                    bf16_t* pp = P + (size_t)row * LDP + pn * 256 + hp * 128 + d0;
                    *(u32x4*)pp = pack8_bf16(o1a, o1b); *(u32x4*)(pp + 64) = pack8_bf16(o2a, o2b); }
        } else {
#pragma unroll
            for (int ai = 0; ai < 2; ++ai)
#pragma unroll
                for (int m = 0; m < 4; ++m) { bf16_t* pp = P + (size_t)(row0 + ai * HALF + m * 16) * LDP + pn * 256 + wc * 32 + 8 * fq;
#pragma unroll
                    for (int bj = 0; bj < 2; ++bj) *(u32x4*)(pp + bj * HALF) = pack8_bf16(acc[ai][bj][m][0], acc[ai][bj][m][1]); }
        }
    }
};
struct EpiSiluH {
    static constexpr bool PERM = true, AFTER_DRAIN = false;
    bf16_t* H;
    __device__ __forceinline__ void operator()(const f32x4 (&acc)[2][2][4][2], const Unit& u, int wr, int wc, int fr, int fq) const {
        const int row0 = u.pm * BM + wr * 64 + fr;
#pragma unroll
        for (int ai = 0; ai < 2; ++ai)
#pragma unroll
            for (int m = 0; m < 4; ++m) { bf16_t* pp = H + (size_t)((row0 + ai * HALF + m * 16) & 2047) * 512 + u.pn * 256 + wc * 32 + 8 * fq;
#pragma unroll
                for (int bj = 0; bj < 2; ++bj) { f32x4 v0, v1;
#pragma unroll
                    for (int j = 0; j < 4; ++j) { v0[j] = silu_f(acc[ai][bj][m][0][j]); v1[j] = silu_f(acc[ai][bj][m][1][j]); }
                    *(u32x4*)(pp + bj * HALF) = pack8_bf16(v0, v1); } }
    }
};
struct EpiKCVC {
    static constexpr bool PERM = true, AFTER_DRAIN = false;
    bf16_t* KC; bf16_t* VCT;
    __device__ __forceinline__ void operator()(const f32x4 (&acc)[2][2][4][2], const Unit& u, int wr, int wc, int fr, int fq) const {
        const int row0 = u.pm * BM + wr * 64 + fr, c0 = wc * 32 + 8 * fq;
#pragma unroll
        for (int ai = 0; ai < 2; ++ai)
#pragma unroll
            for (int m = 0; m < 4; ++m) { const int row = row0 + ai * HALF + m * 16, bg = row >> 7, n = row & 127;
                *(u32x4*)(KC + (size_t)row * 128 + c0) = pack8_bf16(acc[ai][0][m][0], acc[ai][0][m][1]);
#pragma unroll
                for (int nn = 0; nn < 2; ++nn)
#pragma unroll
                    for (int j = 0; j < 4; ++j) { const float v = acc[ai][1][m][nn][j]; VCT[((size_t)bg * 128 + c0 + 4 * nn + j) * 128 + n] = (bf16_t)(cvt_pk_bf16(v, v) & 0xffffu); } }
    }
};
struct EpiAtomicH {
    static constexpr bool PERM = false, AFTER_DRAIN = false;
    float* H;
    __device__ __forceinline__ void operator()(const f32x4 (&acc)[2][2][4][2], const Unit& u, int wr, int wc, int fr, int fq) const {
        const int row0 = u.pm * BM + wr * 64 + fr, col0 = u.pn * 256 + wc * 32 + 4 * fq; float* Hs = H + (size_t)(u.ko >> 10) * (2048 * 512);
#pragma unroll
        for (int ai = 0; ai < 2; ++ai)
#pragma unroll
            for (int m = 0; m < 4; ++m) { float* rp = Hs + (size_t)((row0 + ai * HALF + m * 16) & 2047) * 512 + col0;
#pragma unroll
                for (int bj = 0; bj < 2; ++bj)
#pragma unroll
                    for (int n = 0; n < 2; ++n) *(f32x4*)(rp + bj * HALF + n * 16) = acc[ai][bj][m][n]; }
    }
};
struct SplitOrder {
    int c;
    __device__ bool next(int i, Unit& u) const { if (i > 0 || c >= 128) return false; u.pm = c >> 3; u.pn = c >> 6; u.ko = (c & 7) * 512 * 2; return true; }
    __device__ __forceinline__ void a_ready(const Unit&) const {}
    __device__ __forceinline__ void done(const Unit&) const {}
};
struct HotOrder {
    int nwg, G, c;
    __device__ bool next(int i, Unit& u) const { const long L = (long)i * G + c; if (L >= nwg) return false; u.pm = 0; u.pn = c & 7; return true; }
    __device__ __forceinline__ void a_ready(const Unit&) const {}
    __device__ __forceinline__ void done(const Unit&) const {}
};
struct DiagOrder {
    int c;
    __device__ bool next(int i, Unit& u) const { if (i > 0 || c >= 16) return false; u.pm = c; u.pn = c >> 3; return true; }
    __device__ __forceinline__ void a_ready(const Unit&) const {}
    __device__ __forceinline__ void done(const Unit&) const {}
};
template <class Epi, class Sched, bool ALIGN_EPI = false, bool SP2 = false>
__device__ __forceinline__ void gemm_phase(PG8_LAS unsigned char* lds, const Gemm g, const Sched& S, const Epi& E, unsigned long long*  ) {
    const int tid = opaque_tid(), wid = __builtin_amdgcn_readfirstlane(tid >> 6), lane = tid & 63, wr = wid >> 2, wc = wid & 3, fr = lane & 15, fq = lane >> 4;
    const int K = g.K, nt = (g.Kl ? g.Kl : K) / BK;
    unsigned voffA[2], voffB[2];
#pragma unroll
    for (int i = 0; i < 2; ++i) { int R, C; stage_rc(tid * 16 + i * 8192, R, C); const int Rb = Epi::PERM ? ((R & ~31) + perm32(R & 31)) : R;
        voffA[i] = (unsigned)(R * K + C) * 2u; voffB[i] = (unsigned)(Rb * K + C) * 2u; }
    const size_t kstep = (size_t)(BK * 2);
    const size_t hstep = (size_t)HALF * K * 2;
    const size_t tstep = 2 * hstep;
    const unsigned ldsw = (unsigned)wid * 1024u;
    const int aoff = lds_byte(wr * 64 + fr, fq * 8), boff = lds_byte(wc * 32 + fr, fq * 8);
#define PG8_SA(b, h) (((b) * 2 + (h)) * HTB)
#define PG8_SB(b, h) ((4 + (b) * 2 + (h)) * HTB)
#define PG8_STAGE(bufoff, gbase, voff) do { _Pragma("unroll") for (int _i = 0; _i < 2; ++_i) \
        __builtin_amdgcn_global_load_lds((const unsigned*)((const char*)(gbase) + (voff)[_i]), (PG8_LAS unsigned*)(lds + (bufoff) + ldsw + _i * 8192), 16, 0, 0); } while (0)
#define PG8_LDA(dst, b, h) do { _Pragma("unroll") for (int m = 0; m < 4; ++m) _Pragma("unroll") for (int k = 0; k < 2; ++k) dst[m][k] = *(const PG8_LAS bf16x8*)(lds + PG8_SA(b, h) + aoff + m * 2048 + k * 1024); } while (0)
#define PG8_LDB(dst, b, h) do { _Pragma("unroll") for (int n = 0; n < 2; ++n) _Pragma("unroll") for (int k = 0; k < 2; ++k) dst[n][k] = *(const PG8_LAS bf16x8*)(lds + PG8_SB(b, h) + boff + n * 2048 + k * 1024); } while (0)
#define PG8_MMA(ai, bj, At, Bt) do { __builtin_amdgcn_s_setprio(1); _Pragma("unroll") for (int m = 0; m < 4; ++m) _Pragma("unroll") for (int n = 0; n < 2; ++n) _Pragma("unroll") for (int k = 0; k < 2; ++k) \
        acc[ai][bj][m][n] = __builtin_amdgcn_mfma_f32_16x16x32_bf16(Bt[n][k], At[m][k], acc[ai][bj][m][n], 0, 0, 0); __builtin_amdgcn_s_setprio(0); } while (0)
#define PG8_WAIT_V(n) asm volatile("s_waitcnt vmcnt(" #n ")" ::: "memory")
#define PG8_WAIT_L(n) asm volatile("s_waitcnt lgkmcnt(" #n ")" ::: "memory")
#define PG8_BAR __builtin_amdgcn_s_barrier()
#define PG8_SCHED __builtin_amdgcn_sched_barrier(0)
    Unit cur, nxt; int ui = 0;
    if (!S.next(0, cur)) return;
    f32x4 acc[2][2][4][2];
#pragma unroll
    for (int a = 0; a < 2; ++a)
#pragma unroll
        for (int b = 0; b < 2; ++b)
#pragma unroll
            for (int m = 0; m < 4; ++m)
#pragma unroll
                for (int n = 0; n < 2; ++n) acc[a][b][m][n] = (f32x4){0.f, 0.f, 0.f, 0.f};
    bf16x8 At[4][2], B0[2][2], B1[2][2];
    const char* cA = (const char*)g.A + (size_t)cur.pm * tstep + cur.ko; const char* cB = (const char*)g.Bt + (size_t)cur.pn * tstep + cur.ko;
    S.a_ready(cur);
    if constexpr (SP2) {
        PG8_STAGE(PG8_SB(0, 0), cB, voffB); PG8_STAGE(PG8_SB(0, 1), cB + hstep, voffB); PG8_STAGE(PG8_SA(0, 0), cA, voffA); PG8_STAGE(PG8_SA(0, 1), cA + hstep, voffA);
        if (wr == 1) PG8_BAR;
        PG8_WAIT_V(2); PG8_BAR;
        PG8_STAGE(PG8_SB(1, 0), cB + kstep, voffB); PG8_STAGE(PG8_SA(1, 0), cA + kstep, voffA); PG8_STAGE(PG8_SB(1, 1), cB + hstep + kstep, voffB);
        PG8_WAIT_V(6); PG8_BAR;
    } else {
        PG8_STAGE(PG8_SB(0, 0), cB, voffB); PG8_STAGE(PG8_SA(0, 0), cA, voffA); PG8_STAGE(PG8_SB(0, 1), cB + hstep, voffB); PG8_STAGE(PG8_SA(0, 1), cA + hstep, voffA);
        if (wr == 1) PG8_BAR;
        PG8_WAIT_V(4); PG8_BAR;
        PG8_STAGE(PG8_SB(1, 0), cB + kstep, voffB); PG8_STAGE(PG8_SA(1, 0), cA + kstep, voffA); PG8_STAGE(PG8_SB(1, 1), cB + hstep + kstep, voffB);
        PG8_WAIT_V(6); PG8_BAR;
    }
    for (;;) {
        const bool has_next = S.next(ui + 1, nxt);
        const char* nA = has_next ? (const char*)g.A + (size_t)nxt.pm * tstep + nxt.ko : cA; const char* nB = has_next ? (const char*)g.Bt + (size_t)nxt.pn * tstep + nxt.ko : cB;
        for (int t = 0; t < nt; t += 2) {
            const bool last = (t == nt - 2);
            const char* a1 = cA + (size_t)(t + 1) * kstep;
            const char* a2 = last ? nA : cA + (size_t)(t + 2) * kstep; const char* b2 = last ? nB : cB + (size_t)(t + 2) * kstep;
            const char* a3 = a2 + kstep; const char* b3 = b2 + kstep;
            if (last && has_next) S.a_ready(nxt);
            if constexpr (SP2) {
            PG8_LDB(B0, 0, 0); PG8_LDB(B1, 0, 1); PG8_SCHED; PG8_LDA(At, 0, 0); PG8_STAGE(PG8_SA(1, 1), a1 + hstep, voffA);
            PG8_WAIT_V(8); PG8_WAIT_L(0); PG8_BAR; PG8_MMA(0, 0, At, B0); PG8_MMA(0, 1, At, B1); PG8_BAR; PG8_SCHED;
            PG8_LDA(At, 0, 1); PG8_STAGE(PG8_SB(0, 0), b2, voffB); PG8_STAGE(PG8_SB(0, 1), b2 + hstep, voffB); PG8_STAGE(PG8_SA(0, 0), a2, voffA);
            PG8_WAIT_V(8); PG8_WAIT_L(0); PG8_BAR; PG8_MMA(1, 0, At, B0); PG8_MMA(1, 1, At, B1); PG8_BAR; PG8_SCHED;
            PG8_LDB(B0, 1, 0); PG8_LDB(B1, 1, 1); PG8_SCHED; PG8_LDA(At, 1, 0); PG8_STAGE(PG8_SA(0, 1), a2 + hstep, voffA);
            PG8_WAIT_V(8); PG8_WAIT_L(0); PG8_BAR; PG8_MMA(0, 0, At, B0); PG8_MMA(0, 1, At, B1); PG8_BAR; PG8_SCHED;
            PG8_LDA(At, 1, 1); PG8_STAGE(PG8_SB(1, 0), b3, voffB); PG8_STAGE(PG8_SB(1, 1), b3 + hstep, voffB); PG8_STAGE(PG8_SA(1, 0), a3, voffA);
            PG8_WAIT_V(8); PG8_WAIT_L(0); PG8_BAR; PG8_MMA(1, 0, At, B0); PG8_MMA(1, 1, At, B1); PG8_BAR; PG8_SCHED;
            } else {
            PG8_LDB(B0, 0, 0); PG8_SCHED; PG8_LDA(At, 0, 0); PG8_STAGE(PG8_SA(1, 1), a1 + hstep, voffA);
            PG8_WAIT_L(8); PG8_BAR; PG8_WAIT_L(0); PG8_MMA(0, 0, At, B0); PG8_BAR; PG8_SCHED;
            PG8_LDB(B1, 0, 1); PG8_STAGE(PG8_SB(0, 0), b2, voffB);
            PG8_BAR; PG8_WAIT_L(0); PG8_MMA(0, 1, At, B1); PG8_BAR;
            PG8_LDA(At, 0, 1); PG8_STAGE(PG8_SA(0, 0), a2, voffA);
            PG8_BAR; PG8_WAIT_L(0); PG8_MMA(1, 0, At, B0); PG8_BAR; PG8_SCHED;
            PG8_STAGE(PG8_SB(0, 1), b2 + hstep, voffB);
            PG8_WAIT_V(6); PG8_BAR; PG8_MMA(1, 1, At, B1); PG8_BAR;
            PG8_LDB(B0, 1, 0); PG8_SCHED; PG8_LDA(At, 1, 0); PG8_STAGE(PG8_SA(0, 1), a2 + hstep, voffA);
            PG8_WAIT_L(8); PG8_BAR; PG8_WAIT_L(0); PG8_MMA(0, 0, At, B0); PG8_BAR; PG8_SCHED;
            PG8_LDB(B1, 1, 1); PG8_STAGE(PG8_SB(1, 0), b3, voffB);
            PG8_BAR; PG8_WAIT_L(0); PG8_MMA(0, 1, At, B1); PG8_BAR;
            PG8_LDA(At, 1, 1); PG8_STAGE(PG8_SA(1, 0), a3, voffA);
            PG8_BAR; PG8_WAIT_L(0); PG8_MMA(1, 0, At, B0); PG8_BAR; PG8_SCHED;
            PG8_STAGE(PG8_SB(1, 1), b3 + hstep, voffB);
            PG8_WAIT_V(6); PG8_BAR; PG8_MMA(1, 1, At, B1); PG8_BAR;
            }
        }
        if constexpr (ALIGN_EPI) { if (wr == 0) PG8_BAR; }
        if constexpr (!Epi::AFTER_DRAIN) { E(acc, cur, wr, wc, fr, fq); S.done(cur); }
        if (!has_next) break;
#pragma unroll
        for (int a = 0; a < 2; ++a)
#pragma unroll
            for (int b = 0; b < 2; ++b)
#pragma unroll
                for (int m = 0; m < 4; ++m)
#pragma unroll
                    for (int n = 0; n < 2; ++n) acc[a][b][m][n] = (f32x4){0.f, 0.f, 0.f, 0.f};
        cur = nxt; cA = nA; cB = nB; ++ui;
        if constexpr (ALIGN_EPI) { if (wr == 1) PG8_BAR; }
    }
    PG8_WAIT_V(0);
    if constexpr (!ALIGN_EPI) { if (wr == 0) PG8_BAR; }
    PG8_BAR;
    if constexpr (Epi::AFTER_DRAIN) { E.fused(acc, cur, wr, wc, fr, fq, lds, wid, lane); S.done(cur); }
#undef PG8_SA
#undef PG8_SB
#undef PG8_STAGE
#undef PG8_LDA
#undef PG8_LDB
#undef PG8_MMA
#undef PG8_WAIT_V
#undef PG8_WAIT_L
#undef PG8_BAR
#undef PG8_SCHED
}
}
namespace att {
constexpr int D = 128; constexpr float THR = 8.f; constexpr bool WSKIP = false; constexpr int LDQ = LDP, LDK = LDP, LDO = 1024;
constexpr float SCALE = 0.08838834764831845f;
constexpr int NW = 8, QBLK = 32, KVBLK = 64, QB = NW * QBLK;
constexpr int SHM_V = KVBLK * D * 2, SHM_K = KVBLK * D * 2;
constexpr int LDS_BYTES = 2 * SHM_V + 2 * SHM_K + NW * 64 * 4;

using bf16 = __hip_bfloat16;
typedef short bf16x8 __attribute__((ext_vector_type(8)));
typedef short s16x4 __attribute__((ext_vector_type(4)));
typedef float f32x16 __attribute__((ext_vector_type(16)));
typedef float f32x4 __attribute__((ext_vector_type(4)));
typedef unsigned u32x4 __attribute__((ext_vector_type(4)));
template <class A, class Bt> struct same_t { static constexpr bool v = false; };
template <class A> struct same_t<A, A> { static constexpr bool v = true; };

#define KSWZ(row, colB) ((row) * 256 + ((colB) ^ (((row) & 7) << 4)))
#define SBAR() __builtin_amdgcn_sched_barrier(0)
__device__ __forceinline__ int v_st(int k, int c) { const int kk = (k & ~0xC) | ((k & 4) << 1) | ((k & 8) >> 1); return ((kk >> 3) * 4 + (c >> 5)) * 512 + ((kk & 7) * 32 + (c & 31)) * 2; }
__device__ __forceinline__ int v_rd_base(int lane) { return ((lane & 3) << 3) | (((lane >> 2) & 3) << 6) | (((lane >> 4) & 1) << 5) | (((lane >> 5) & 1) << 8); }
constexpr int v_rd_off(int d0, int ks, int half) { return d0 * 512 + ks * 4096 + half * 2048; }
__device__ __forceinline__ int crow(int r, int hi) { return (r & 3) + 8 * (r >> 2) + 4 * hi; }
__device__ __forceinline__ unsigned cvtpk(float lo, float hi) {
    unsigned r; asm volatile("v_cvt_pk_bf16_f32 %0, %1, %2" : "=v"(r) : "v"(lo), "v"(hi)); return r;
}
__device__ __forceinline__ bf16x8 pack8(f32x4 a, f32x4 b) {
    u32x4 w = {cvtpk(a[0], a[1]), cvtpk(a[2], a[3]), cvtpk(b[0], b[1]), cvtpk(b[2], b[3])};
    return *reinterpret_cast<bf16x8*>(&w);
}
template <class T> __device__ __forceinline__ bf16x8 load8(const T* p) {
    if constexpr (same_t<T, float>::v) { return pack8(*(const f32x4*)p, *(const f32x4*)(p + 4)); }
    else { return *reinterpret_cast<const bf16x8*>(p); }
}
__device__ __forceinline__ void mask_tile(f32x16& p0, f32x16& p1, int dq, unsigned W) {
    const float NEG = -__builtin_inff();
#pragma unroll
    for (int r = 0; r < 16; ++r) {
        const int c = (r & 3) + 8 * (r >> 2);
        if ((unsigned)(dq - c) >= W) p0[r] = NEG;
        if ((unsigned)(dq - c - 32) >= W) p1[r] = NEG;
    }
}
__device__ __forceinline__ void partialSM(f32x16& p0, f32x16& p1, float& m_reg, float& mn, float& alpha) {
    float pmax = p0[0]; for (int r = 1; r < 16; ++r) pmax = fmaxf(pmax, p0[r]); for (int r = 0; r < 16; ++r) pmax = fmaxf(pmax, p1[r]);
    { auto rr = __builtin_amdgcn_permlane32_swap(__float_as_uint(pmax), __float_as_uint(pmax), false, false);
      pmax = fmaxf(__uint_as_float(rr[0]), __uint_as_float(rr[1])); }
    constexpr float C2 = 1.4426950408889634f * SCALE;
    if (__builtin_expect(__all((pmax - m_reg) * SCALE <= THR), 1)) { mn = m_reg; alpha = 1.f; }
    else { mn = fmaxf(m_reg, pmax); alpha = __builtin_amdgcn_exp2f((m_reg - mn) * C2); m_reg = mn; }
    const float mnL = -mn * C2;
    for (int r = 0; r < 16; ++r) p0[r] = fmaf(p0[r], C2, mnL); for (int r = 0; r < 16; ++r) p1[r] = fmaf(p1[r], C2, mnL);
    for (int r = 0; r < 16; ++r) p0[r] = __builtin_amdgcn_exp2f(p0[r]);
}
__device__ __forceinline__ void finishSM(f32x16& p0, f32x16& p1, float alpha, float& l_reg, bf16x8& pa0, bf16x8& pa1, bf16x8& pa2, bf16x8& pa3) {
    for (int r = 0; r < 16; ++r) p1[r] = __builtin_amdgcn_exp2f(p1[r]);
    float ps = 0; for (int r = 0; r < 16; ++r) ps += p0[r]; for (int r = 0; r < 16; ++r) ps += p1[r];
    { auto rr = __builtin_amdgcn_permlane32_swap(__float_as_uint(ps), __float_as_uint(ps), false, false);
      ps = __uint_as_float(rr[0]) + __uint_as_float(rr[1]); }
    l_reg = l_reg * alpha + ps;
#define PK4(P, B_, OUT) do { unsigned a0 = cvtpk(P[B_+0], P[B_+1]), a1 = cvtpk(P[B_+2], P[B_+3]);                          \
        unsigned b0 = cvtpk(P[B_+4], P[B_+5]), b1 = cvtpk(P[B_+6], P[B_+7]);                                             \
        auto r0 = __builtin_amdgcn_permlane32_swap(a0, b0, false, false); auto r1 = __builtin_amdgcn_permlane32_swap(a1, b1, false, false); \
        u32x4 w = {r0[0], r1[0], r0[1], r1[1]}; OUT = *reinterpret_cast<bf16x8*>(&w); } while (0)
    PK4(p0, 0, pa0); PK4(p0, 8, pa1); PK4(p1, 0, pa2); PK4(p1, 8, pa3);
#undef PK4
}
template <int KB, bool SK>
__device__ __forceinline__ void qkt(f32x16& p0, f32x16& p1, const char* K_lds, int r32, int hi, const bf16x8* qr, bool act) {
    if (SK && !act) { const float NEG = -__builtin_inff();
#pragma unroll
        for (int r = 0; r < 16; ++r) { p0[r] = NEG; p1[r] = NEG; } return; }
    p0 = f32x16{}; p1 = f32x16{};
    const char* kb[4];
#pragma unroll
    for (int dd = 0; dd < 4; ++dd) kb[dd] = K_lds + KB * SHM_K + KSWZ(r32, (dd * 16 + hi * 8) * 2);
#pragma unroll
    for (int d0 = 0; d0 < 8; ++d0) { const char* a = kb[d0 & 3] + (d0 >> 2) * 128;
        bf16x8 b0 = *reinterpret_cast<const bf16x8*>(a);
        bf16x8 b1 = *reinterpret_cast<const bf16x8*>(a + 32 * 256);
        p0 = __builtin_amdgcn_mfma_f32_32x32x16_bf16(b0, qr[d0], p0, 0, 0, 0);
        p1 = __builtin_amdgcn_mfma_f32_32x32x16_bf16(b1, qr[d0], p1, 0, 0, 0); }
}
template <int VB, bool SK>
__device__ __forceinline__ void pv_tile(f32x16* o, int vb0, bf16x8 pa0, bf16x8 pa1, bf16x8 pa2, bf16x8 pa3, bool act) {
    if (SK && !act) return;
#define TRRD(dst, off) asm volatile("ds_read_b64_tr_b16 %0, %1 offset:%2" : "=&v"(dst) : "v"(vb0), "i"(off) : "memory")
#define PV_D0(d0) do { s16x4 l0, l1, l2, l3, h0, h1, h2, h3; constexpr int b_ = VB * SHM_V + v_rd_off(d0, 0, 0);     \
        TRRD(l0, b_); TRRD(h0, b_ + 2048); TRRD(l1, b_ + 4096); TRRD(h1, b_ + 6144); TRRD(l2, b_ + 8192); TRRD(h2, b_ + 10240); TRRD(l3, b_ + 12288); TRRD(h3, b_ + 14336); \
        asm volatile("s_waitcnt lgkmcnt(0)" ::: "memory"); SBAR();                 \
        o[d0] = __builtin_amdgcn_mfma_f32_32x32x16_bf16(pa0, (bf16x8){l0[0], l0[1], l0[2], l0[3], h0[0], h0[1], h0[2], h0[3]}, o[d0], 0, 0, 0);   \
        o[d0] = __builtin_amdgcn_mfma_f32_32x32x16_bf16(pa1, (bf16x8){l1[0], l1[1], l1[2], l1[3], h1[0], h1[1], h1[2], h1[3]}, o[d0], 0, 0, 0);   \
        o[d0] = __builtin_amdgcn_mfma_f32_32x32x16_bf16(pa2, (bf16x8){l2[0], l2[1], l2[2], l2[3], h2[0], h2[1], h2[2], h2[3]}, o[d0], 0, 0, 0);   \
        o[d0] = __builtin_amdgcn_mfma_f32_32x32x16_bf16(pa3, (bf16x8){l3[0], l3[1], l3[2], l3[3], h3[0], h3[1], h3[2], h3[3]}, o[d0], 0, 0, 0); } while (0)
    PV_D0(0); PV_D0(1); PV_D0(2); PV_D0(3);
#undef PV_D0
#undef TRRD
}

template <class TIn, class TOut> struct BlockRef { const char* base; unsigned qo, ko, vo, oo, so; int P0; int W;
    __device__ __forceinline__ const TIn* Qp() const { return (const TIn*)(base + qo); }
    __device__ __forceinline__ const TIn* Kp() const { return (const TIn*)(base + ko); }
    __device__ __forceinline__ const TIn* Vp() const { return (const TIn*)(base + vo); }
    __device__ __forceinline__ TOut* Op() const { return (TOut*)(base + oo); }
    __device__ __forceinline__ bool has_sel() const { return so != 0xffffffffu; }
    __device__ __forceinline__ const unsigned* selp() const { return (const unsigned*)(base + so); } };
template <class TIn> struct Seam {
    bf16x8 qr[8];
    bf16x8 st_v0, st_v1, st_k0, st_k1; f32x4 sf0, sf1, sf2, sf3;
    f32x4 tq[16];
};
__device__ __forceinline__ int swa_jlo(int P0, int W) { const int lowk = P0 - W + 1; return lowk > 0 ? lowk / KVBLK : 0; }
#define ROW(p, k0, rr) ((p) + (size_t)(k0) * LDK + (unsigned)((rr) * LDK + sc))
#define VMW() asm volatile("s_waitcnt vmcnt(0)" ::: "memory")
#define VMWN(n) asm volatile("s_waitcnt vmcnt(%0)" :: "i"(n) : "memory")
#define SLOAD_H(Kp, Vp, k0) do { S.st_v0 = load8<TIn>(ROW(Vp, k0, sr)); S.st_v1 = load8<TIn>(ROW(Vp, k0, 32 + sr));              \
                         S.st_k0 = load8<TIn>(ROW(Kp, k0, sr)); S.st_k1 = load8<TIn>(ROW(Kp, k0, 32 + sr)); } while (0)
#define SWRITE_HK(bf) do { *(bf16x8*)(K_lds + (bf) * SHM_K + kws) = S.st_k0; *(bf16x8*)(K_lds + (bf) * SHM_K + kws + 32 * 256) = S.st_k1; } while (0)
#define SWRITE_HV(bf) do { *(bf16x8*)(V_lds + (bf) * SHM_V + vst0) = S.st_v0; *(bf16x8*)(V_lds + (bf) * SHM_V + vst1) = S.st_v1; } while (0)
#define SWRITE_H(bf) do { SWRITE_HV(bf); SWRITE_HK(bf); } while (0)
#define SLOAD_F(p, k0) do { S.sf0 = *(const f32x4*)ROW(p, k0, sr); S.sf1 = *(const f32x4*)(ROW(p, k0, sr) + 4);                \
                            S.sf2 = *(const f32x4*)ROW(p, k0, 32 + sr); S.sf3 = *(const f32x4*)(ROW(p, k0, 32 + sr) + 4); } while (0)
#define SWRITE_KF(bf) do { *(bf16x8*)(K_lds + (bf) * SHM_K + kws) = pack8(S.sf0, S.sf1); *(bf16x8*)(K_lds + (bf) * SHM_K + kws + 32 * 256) = pack8(S.sf2, S.sf3); } while (0)
#define SWRITE_VF(bf) do { *(bf16x8*)(V_lds + (bf) * SHM_V + vst0) = pack8(S.sf0, S.sf1); *(bf16x8*)(V_lds + (bf) * SHM_V + vst1) = pack8(S.sf2, S.sf3); } while (0)
template <class TIn, class TOut>
__device__ __forceinline__ void causal_swa_prime(const BlockRef<TIn, TOut>& cur, char* lds, Seam<TIn>& S) {
    constexpr bool F32 = same_t<TIn, float>::v;
    const int tid = opaque_tid(), wid = __builtin_amdgcn_readfirstlane(tid >> 6), lane = tid & 63, r32 = lane & 31, hi = lane >> 5;
    const int sr = tid >> 4, sc = (tid & 15) * 8, kws = KSWZ(sr, sc * 2); char* K_lds = lds + 2 * SHM_V;
    const int kb0 = swa_jlo(cur.P0, cur.W) * KVBLK;
    for (int d0 = 0; d0 < 8; ++d0) S.qr[d0] = load8<TIn>(cur.Qp() + (size_t)(wid * QBLK) * LDQ + (unsigned)(r32 * LDQ + hi * 8) + d0 * 16);
    if constexpr (F32) { SLOAD_F((const float*)cur.Kp(), kb0); VMW(); SWRITE_KF(0); SBAR(); SLOAD_F((const float*)cur.Vp(), kb0); }
    else { SLOAD_H(cur.Kp(), cur.Vp(), kb0); VMW(); SWRITE_HK(0); }
    __syncthreads();
}
template <class TIn, class TOut>
__device__ __forceinline__ void causal_swa_block(const BlockRef<TIn, TOut>& cur, const BlockRef<TIn, TOut>& nxt, int skv, char* lds, Seam<TIn>& S) {
    constexpr bool F32 = same_t<TIn, float>::v;
    const int tid = opaque_tid(), wid = __builtin_amdgcn_readfirstlane(tid >> 6), lane = tid & 63, r32 = lane & 31, hi = lane >> 5;
    const int W = cur.W;
    const int j_lo = swa_jlo(cur.P0, W);
    const unsigned selw = cur.has_sel() ? cur.selp()[wid * QBLK + r32] : 0xffffffffu;
    int j_hi = (cur.P0 + QB - 1) / KVBLK + 1; if (j_hi > skv / KVBLK) j_hi = skv / KVBLK;
    const int NT = j_hi - j_lo;
    const int kbn = swa_jlo(nxt.P0, nxt.W) * KVBLK;
    const int qlo = cur.P0 + wid * QBLK, qm = qlo + r32 - 4 * hi;
    char* V_lds = lds; char* K_lds = lds + 2 * SHM_V;
    float* ws = (float*)(lds + 2 * SHM_V + 2 * SHM_K) + wid * 64; float* li_l = ws, * al_l = ws + 32;
    float m_reg = -1e30f, l_reg = 0; f32x16 o[4] = {};
    const int sr = tid >> 4, sc = (tid & 15) * 8, vst0 = v_st(sr, sc), vst1 = v_st(32 + sr, sc), kws = KSWZ(sr, sc * 2);
    const int vb0 = (int)(uintptr_t)V_lds + v_rd_base(lane);
    const TIn* Kh = cur.Kp(); const TIn* Vh = cur.Vp();
#define RESC(a) do { if (__any((a) < 1.f)) { if (hi == 0) al_l[r32] = (a); asm volatile("s_waitcnt lgkmcnt(0)" ::: "memory");              \
                     for (int d_ = 0; d_ < 4; ++d_) for (int r = 0; r < 16; ++r) o[d_][r] *= al_l[crow(r, hi)]; } } while (0)
#define KBASE(t) ((j_lo + (t)) * KVBLK)
#define ACT(t) (KBASE(t) <= qlo + QBLK - 1 && KBASE(t) + KVBLK - 1 >= qlo - W + 1)
#define MASKT(P0_, P1_, t) do { const int kb_ = KBASE(t); if ((!SK || ACT(t)) && (kb_ + KVBLK - 1 > qlo || kb_ <= qlo + QBLK - 1 - W)) mask_tile(P0_, P1_, qm - kb_, (unsigned)W); \
        if (cur.has_sel()) { if (!((selw >> (j_lo + (t))) & 1u)) { const float NEG_ = -__builtin_inff(); _Pragma("unroll") for (int r_ = 0; r_ < 16; ++r_) { P0_[r_] = NEG_; P1_[r_] = NEG_; } } } } while (0)
    constexpr int NQL = F32 ? 16 : 8;
    constexpr bool SK = WSKIP && !F32;
#define SEAM_K0() do { VMWN(NQL); if constexpr (F32) { SWRITE_KF(0); SBAR(); SLOAD_F((const float*)nxt.Vp(), kbn); } else { SWRITE_HK(0); } SBAR(); } while (0)
    f32x16 pA0, pA1, pB0, pB1; float mnA, mnB, alA, alB; bf16x8 pa0, pa1, pa2, pa3;
    if constexpr (F32) { VMW(); SWRITE_VF(0); SBAR(); } else { SWRITE_HV(0); SBAR(); }
    if (NT > 1) { if constexpr (F32) SLOAD_F((const float*)Kh, KBASE(1)); else SLOAD_H(Kh, Vh, KBASE(1)); }
    SBAR(); qkt<0, SK>(pA0, pA1, K_lds, r32, hi, S.qr, ACT(0));
    if constexpr (F32) { if (NT > 1) { VMW(); SWRITE_KF(1); SBAR(); SLOAD_F((const float*)Vh, KBASE(1)); } }
    MASKT(pA0, pA1, 0); partialSM(pA0, pA1, m_reg, mnA, alA);
    if (NT > 1) { VMW(); if constexpr (F32) { SWRITE_VF(1); SBAR(); if (NT > 2) SLOAD_F((const float*)Kh, KBASE(2)); } else SWRITE_H(1); }
    __syncthreads();
#define HALF_STEP(PX0, PX1, mnX, alX, PY0, PY1, alY, t, KB, VB, SB) do {                                                      \
        SBAR(); qkt<KB, SK>(PX0, PX1, K_lds, r32, hi, S.qr, ACT(t));                                             \
        finishSM(PY0, PY1, alY, l_reg, pa0, pa1, pa2, pa3); SBAR();                                                           \
        if ((t) + 1 < NT) { if constexpr (F32) { VMW(); SWRITE_KF(SB); SBAR(); SLOAD_F((const float*)Vh, KBASE((t) + 1)); }  \
                            else { SLOAD_H(Kh, Vh, KBASE((t) + 1)); } SBAR(); }                                               \
        pv_tile<VB, SK>(o, vb0, pa0, pa1, pa2, pa3, ACT((t) - 1)); MASKT(PX0, PX1, (t)); partialSM(PX0, PX1, m_reg, mnX, alX);                                        \
        __syncthreads();                                                                                                      \
        if ((t) + 1 < NT) { VMW(); if constexpr (F32) { SWRITE_VF(SB); SBAR(); if ((t) + 2 < NT) SLOAD_F((const float*)Kh, KBASE((t) + 2)); } \
                            else { SWRITE_H(SB); } }                                                                          \
        RESC(alX); __syncthreads(); } while (0)
    for (int t = 1; t + 1 < NT; t += 2) {
        HALF_STEP(pB0, pB1, mnB, alB, pA0, pA1, alA, t, 1, 0, 0);
        HALF_STEP(pA0, pA1, mnA, alA, pB0, pB1, alB, t + 1, 0, 1, 1);
    }
    const bool even = (NT & 1) == 0;
    if (even) { SBAR(); qkt<1, SK>(pB0, pB1, K_lds, r32, hi, S.qr, ACT(NT - 1)); SBAR(); }
#define QROW(e) (nxt.Qp() + (size_t)(wid * QBLK + r32) * LDQ + ((e) >> 1) * 16 + hi * 8 + ((e) & 1) * 4)
    if constexpr (F32) { SLOAD_F((const float*)nxt.Kp(), kbn); SBAR();
#pragma unroll
        for (int e = 0; e < 8; ++e) S.tq[e] = *(const f32x4*)QROW(e); }
    else { SLOAD_H(nxt.Kp(), nxt.Vp(), kbn); SBAR();
#pragma unroll
        for (int d0 = 0; d0 < 8; ++d0) S.qr[d0] = load8<TIn>(nxt.Qp() + (size_t)(wid * QBLK) * LDQ + (unsigned)(r32 * LDQ + hi * 8) + d0 * 16); }
    SBAR();
    finishSM(pA0, pA1, alA, l_reg, pa0, pa1, pa2, pa3); SBAR();
    if constexpr (F32) {
#pragma unroll
        for (int e = 8; e < 16; ++e) S.tq[e] = *(const f32x4*)QROW(e); SBAR(); }
#undef QROW
    pv_tile<0, SK>(o, vb0, pa0, pa1, pa2, pa3, ACT(even ? NT - 2 : NT - 1));
    if (even) { MASKT(pB0, pB1, NT - 1); partialSM(pB0, pB1, m_reg, mnB, alB); __syncthreads(); RESC(alB);
        finishSM(pB0, pB1, alB, l_reg, pa0, pa1, pa2, pa3); SBAR(); pv_tile<1, SK>(o, vb0, pa0, pa1, pa2, pa3, ACT(NT - 1)); }
    SBAR(); SEAM_K0();
    if (hi == 0) li_l[r32] = l_reg; asm volatile("s_waitcnt lgkmcnt(0)" ::: "memory");
    float rli[16];
#pragma unroll
    for (int r = 0; r < 16; ++r) rli[r] = __builtin_amdgcn_rcpf(li_l[crow(r, hi)]);
    TOut* Ow = cur.Op() + (size_t)(wid * QBLK) * LDO;
#pragma unroll
    for (int r = 0; r < 16; ++r) { const int orow = crow(r, hi);
#pragma unroll
        for (int d0 = 0; d0 < 4; ++d0) { const float v = o[d0][r] * rli[r];
            if constexpr (same_t<TOut, float>::v) { Ow[(size_t)orow * LDO + d0 * 32 + r32] = v; }
            else { const float vn = __shfl_xor(v, 1);
                   if ((r32 & 1) == 0) *(unsigned*)(Ow + (size_t)orow * LDO + d0 * 32 + r32) = cvtpk(v, vn); } } }
    if constexpr (F32) {
#pragma unroll
        for (int d0 = 0; d0 < 8; ++d0) S.qr[d0] = pack8(S.tq[2 * d0], S.tq[2 * d0 + 1]); }
    __syncthreads();
#undef RESC
#undef KBASE
#undef ACT
#undef MASKT
#undef SEAM_K0
#undef HALF_STEP
}
#undef ROW
#undef VMW
#undef VMWN
#undef SLOAD_H
#undef SWRITE_HK
#undef SWRITE_HV
#undef SWRITE_H
#undef SLOAD_F
#undef SWRITE_KF
#undef SWRITE_VF

}
typedef unsigned short bf16_t;
typedef short bf16x8 __attribute__((ext_vector_type(8)));
typedef float f32x4 __attribute__((ext_vector_type(4)));
typedef float f32x16 __attribute__((ext_vector_type(16)));
typedef unsigned u32x4 __attribute__((ext_vector_type(4)));
typedef unsigned u32x2 __attribute__((ext_vector_type(2)));
constexpr size_t SZ_WA = (size_t)11264 * 2048 * 2, SZ_WD = (size_t)2048 * 5632 * 2, SZ_WIN = (size_t)NPROJ * 2048 * 2, SZ_WOUT = (size_t)2048 * 2048 * 2,
                 SZ_WC1 = (size_t)512 * 4096 * 2, SZ_WC2 = (size_t)256 * 512 * 2;
constexpr size_t OFF_W1A = 0, OFF_W1D = OFF_W1A + SZ_WA, OFF_W2A = OFF_W1D + SZ_WD, OFF_W2D = OFF_W2A + SZ_WA, OFF_WIN = OFF_W2D + SZ_WD, OFF_WOUT = OFF_WIN + SZ_WIN,
                 OFF_WC1 = OFF_WOUT + SZ_WOUT, OFF_WC2 = OFF_WC1 + SZ_WC1, SZ_LAYER = OFF_WC2 + SZ_WC2;
constexpr size_t SZ_O = (size_t)M_TOK * 1024 * 2;
constexpr size_t WS_HB = 2 * SZ_LAYER, WS_XR = WS_HB  , WS_ACT = WS_HB + (size_t)M_TOK * DM * 2, WS_GATES = WS_ACT + (size_t)M_TOK * DFF * 2, WS_OCMP = WS_GATES + (size_t)M_TOK * 32 * 4,
                 WS_OSLC = WS_OCMP + SZ_O, WS_OWIN = WS_OSLC + SZ_O, WS_OD1 = WS_OWIN + SZ_O, WS_OD2 = WS_OD1 + SZ_O, WS_AKV = WS_OD1  ,
                 WS_HC = WS_OD2 + SZ_O, WS_KC = WS_HC + (size_t)2048 * 512 * 2, WS_VCT = WS_KC + (size_t)16 * 128 * 128 * 2, WS_SELM = WS_VCT + (size_t)16 * 128 * 128 * 2,
                 WS_ROPEC = WS_SELM + (size_t)16 * 2048 * 4, WS_ROPES = WS_ROPEC + (size_t)2048 * 64 * 4, WS_BAR = WS_ROPES + (size_t)2048 * 64 * 4, WS_ITEMS = WS_BAR + 16384, WS_HPRE = WS_ITEMS + (size_t)2048 * 8 * 4, WS_SSQ = WS_HPRE + (size_t)8 * 2048 * 512 * 4, WS_PT = WS_SSQ + (size_t)M_TOK * 32 * 4, WS_END = WS_PT + (size_t)4 * 64 * 256 * 4;
static_assert(SZ_LAYER % 256 == 0 && (size_t)4096 * 4096 * 2 == SZ_O, "layout");

struct Params { const float* in[24]; float* out; unsigned char* ws; };
typedef const __attribute__((address_space(4))) Params* KParamsPtr;

__device__ __forceinline__ unsigned cvtpk2(float lo, float hi) { unsigned r; asm volatile("v_cvt_pk_bf16_f32 %0, %1, %2" : "=v"(r) : "v"(lo), "v"(hi)); return r; }
__device__ __forceinline__ float bf_lo(unsigned w) { return __uint_as_float(w << 16); }
__device__ __forceinline__ float bf_hi(unsigned w) { return __uint_as_float(w & 0xffff0000u); }

__device__ __forceinline__ void tc_tile4(const float* __restrict__ src, int ld_src, int col0, int ncv, int ks0, bf16_t* __restrict__ dst, int ld_dst, int row0, int kd0, float* tile, const float* __restrict__ gk = nullptr) {
    const int tid = opaque_tid(), cc = tid & 63, kb = tid >> 6;
    float v[32];
    const bool ok = ks0 >= 0 && cc < ncv;
    const float* sp = src + (size_t)((ks0 >= 0 ? ks0 : 0) + kb) * ld_src + col0 + (cc < ncv ? cc : 0);
#pragma unroll
    for (int i = 0; i < 32; ++i) v[i] = ok ? sp[(size_t)(8 * i) * ld_src] : 0.f;
    if (gk && ks0 >= 0) {
#pragma unroll
        for (int i = 0; i < 32; ++i) v[i] *= gk[ks0 + kb + 8 * i]; }
#pragma unroll
    for (int i = 0; i < 32; ++i) tile[(kb + 8 * i) * 65 + cc] = v[i];
    __syncthreads();
    const int rr = tid >> 3, kq = (tid & 7) * 8;
#pragma unroll
    for (int jx = 0; jx < 4; ++jx) { const int k0 = kq + 64 * jx; u32x4 w;
        w.x = cvtpk2(tile[(k0 + 0) * 65 + rr], tile[(k0 + 1) * 65 + rr]); w.y = cvtpk2(tile[(k0 + 2) * 65 + rr], tile[(k0 + 3) * 65 + rr]);
        w.z = cvtpk2(tile[(k0 + 4) * 65 + rr], tile[(k0 + 5) * 65 + rr]); w.w = cvtpk2(tile[(k0 + 6) * 65 + rr], tile[(k0 + 7) * 65 + rr]);
        *(u32x4*)(dst + (size_t)(row0 + rr) * ld_dst + kd0 + k0) = w; }
    __syncthreads();
}
__device__ void prep_phase(KParamsPtr pp_, float* tile) {
    const int G = opaque_gx(), bx = opaque_bx();
    for (int l = 0; l < 2; ++l) {
        unsigned char* wl = pp_->ws + (size_t)l * SZ_LAYER;
        for (int f = 0; f < 2; ++f) {
            const float* gate = pp_->in[f ? 20 : 2] + (size_t)l * DM * DFF; const float* up = pp_->in[f ? 21 : 3] + (size_t)l * DM * DFF; const float* down = pp_->in[f ? 22 : 4] + (size_t)l * DM * DFF;
            bf16_t* dA = (bf16_t*)(wl + (f ? OFF_W2A : OFF_W1A)); bf16_t* dD = (bf16_t*)(wl + (f ? OFF_W2D : OFF_W1D)); const float* gn = pp_->in[f ? 19 : 1] + (size_t)l * DM;
            for (int tix = bx; tix < 176 * 8; tix += G) { const int rg = tix >> 3, kg = tix & 7, pp = rg >> 2, q = rg & 3;
                tc_tile4(q < 2 ? gate : up, DFF, 128 * pp + 64 * (q & 1), 64, kg * 256, dA, DM, rg * 64, kg * 256, tile, gn); }
            for (int tix = bx; tix < 32 * 22; tix += G) { const int rg = tix / 22, kg = tix - rg * 22;
                tc_tile4(down, DM, 64 * rg, 64, kg * 256, dD, DFF, rg * 64, kg * 256, tile); }
        }
        { const float* w = pp_->in[6] + (size_t)l * DM * 5656; bf16_t* dst = (bf16_t*)(wl + OFF_WIN); const float* gn = pp_->in[5] + (size_t)l * DM;
          for (int tix = bx; tix < 92 * 8; tix += G) { const int rg = tix >> 3, kg = tix & 7, pn = rg >> 2, q = rg & 3; int col0 = 0, ncv = 64, ks0 = kg * 256;
              if (pn == 22) { if (q == 0) { col0 = 2560; ncv = 24; } else ks0 = -1; }
              else { const int pcol = is_rope_tile(pn) ? 256 * pn + (q & 1) * 128 + 64 * (q >> 1) : 256 * pn + 64 * q; col0 = pcol < 2560 ? pcol : pcol + 24; }
              tc_tile4(w, 5656, col0, ncv, ks0, dst, DM, rg * 64, kg * 256, tile, gn); } }
        { const float* w = pp_->in[18] + (size_t)l * DM * DM; bf16_t* dst = (bf16_t*)(wl + OFF_WOUT);
          for (int tix = bx; tix < 32 * 8; tix += G) { const int rg = tix >> 3, kg = tix & 7; tc_tile4(w, DM, 64 * rg, 64, kg * 256, dst, DM, rg * 64, kg * 256, tile); } }
        { const float* wk = pp_->in[9] + (size_t)l * 4096 * 256; const float* wv = pp_->in[11] + (size_t)l * 4096 * 256; bf16_t* dst = (bf16_t*)(wl + OFF_WC1);
          for (int tix = bx; tix < 8 * 16; tix += G) { const int rg = tix >> 4, kg = tix & 15; tc_tile4(rg < 4 ? wk : wv, 256, 64 * (rg & 3), 64, kg * 256, dst, 4096, rg * 64, kg * 256, tile); } }
        { const float* wk = pp_->in[10] + (size_t)l * 256 * 128; const float* wv = pp_->in[12] + (size_t)l * 256 * 128; bf16_t* dst = (bf16_t*)(wl + OFF_WC2);
          for (int tix = bx; tix < 4 * 2; tix += G) { const int rg = tix >> 1, kg = tix & 1; const int ks0 = (rg < 2) == (kg == 0) ? 0 : -1;
              tc_tile4(rg < 2 ? wk : wv, 128, 64 * (rg & 1), 64, ks0, dst, 512, rg * 64, kg * 256, tile); } }
    }
    { float* PTP = (float*)(pp_->ws + WS_PT); const int tid_ = opaque_tid(), wv = tid_ >> 6, ln = tid_ & 63;
      if (wv < 4) for (int task = bx * 4 + wv; task < 1024; task += G * 4) { const int l = task >> 9, kv = (task >> 8) & 1, hg = (task >> 6) & 3, kc = task & 63;
          const float* pos = pp_->in[kv ? 8 : 7] + (size_t)l * 4096 + kc * 64; const float* w1 = pp_->in[kv ? 11 : 9] + (size_t)l * 4096 * 256 + (size_t)(kc * 64) * 256 + hg * 64 + ln; float a = 0.f;
#pragma unroll 16
          for (int i = 0; i < 64; ++i) a += pos[i] * w1[(size_t)i * 256];
          PTP[(size_t)((l * 2 + kv) * 64 + kc) * 256 + hg * 64 + ln] = a; } }
    float* rc = (float*)(pp_->ws + WS_ROPEC); float* rs = (float*)(pp_->ws + WS_ROPES);
    for (int i = bx * 512 + opaque_tid(); i < TSEQ * 64; i += G * 512) { const int t = i >> 6, d = i & 63;
        const float inv = __builtin_amdgcn_exp2f(-(float)d * 0.20762050593046014f);
        const float ang = (float)t * inv; float rev = ang * 0.15915494309189535f; rev -= floorf(rev);
        rc[i] = __builtin_amdgcn_cosf(rev); rs[i] = __builtin_amdgcn_sinf(rev); }
}

template <bool IN_BF16, bool TO_BF16>
__device__ void rmsnorm_phase(const void* __restrict__ xin, const float* __restrict__ g, bf16_t* __restrict__ ob, float* __restrict__ of) {
    const int tid_ = opaque_tid(); const int wid = tid_ >> 6, lane = tid_ & 63;
    f32x4 gv[8];
#pragma unroll
    for (int i = 0; i < 8; ++i) gv[i] = *(const f32x4*)(g + (lane + 64 * i) * 4);
    for (int row = opaque_bx() * 8 + wid; row < M_TOK; row += opaque_gx() * 8) {
        f32x4 v[8]; float ss = 0.f;
        if (IN_BF16) { const bf16_t* xr = (const bf16_t*)xin + (size_t)row * DM; u32x2 w[8];
#pragma unroll
            for (int i = 0; i < 8; ++i) w[i] = *(const u32x2*)(xr + (lane + 64 * i) * 4);
#pragma unroll
            for (int i = 0; i < 8; ++i) v[i] = (f32x4){bf_lo(w[i].x), bf_hi(w[i].x), bf_lo(w[i].y), bf_hi(w[i].y)}; }
        else { const float* xr = (const float*)xin + (size_t)row * DM;
#pragma unroll
            for (int i = 0; i < 8; ++i) v[i] = *(const f32x4*)(xr + (lane + 64 * i) * 4); }
#pragma unroll
        for (int i = 0; i < 8; ++i) ss += v[i][0] * v[i][0] + v[i][1] * v[i][1] + v[i][2] * v[i][2] + v[i][3] * v[i][3];
#pragma unroll
        for (int o = 32; o >= 1; o >>= 1) ss += __shfl_xor(ss, o);
        const float rstd = 1.0f / sqrtf(ss * (1.0f / DM) + 1e-6f);
#pragma unroll
        for (int i = 0; i < 8; ++i) { const f32x4 y = v[i] * rstd * gv[i];
            if (TO_BF16) { u32x2 w; w.x = cvtpk2(y[0], y[1]); w.y = cvtpk2(y[2], y[3]); *(u32x2*)(ob + (size_t)row * DM + (lane + 64 * i) * 4) = w; }
            else *(f32x4*)(of + (size_t)row * DM + (lane + 64 * i) * 4) = y; }
    }
}

__device__ void xconv_phase(const float* __restrict__ x, bf16_t* __restrict__ ob, float* __restrict__ ssq) {
    const int tid_ = opaque_tid(); const int wid = tid_ >> 6, lane = tid_ & 63;
    for (int row = opaque_bx() * 8 + wid; row < M_TOK; row += opaque_gx() * 8) {
        const float* xr = x + (size_t)row * DM; f32x4 v[8]; float ss = 0.f;
#pragma unroll
        for (int i = 0; i < 8; ++i) v[i] = *(const f32x4*)(xr + (lane + 64 * i) * 4);
#pragma unroll
        for (int i = 0; i < 8; ++i) { ss += v[i][0] * v[i][0] + v[i][1] * v[i][1] + v[i][2] * v[i][2] + v[i][3] * v[i][3];
            u32x2 w; w.x = cvtpk2(v[i][0], v[i][1]); w.y = cvtpk2(v[i][2], v[i][3]); *(u32x2*)(ob + (size_t)row * DM + (lane + 64 * i) * 4) = w; }
#pragma unroll
        for (int o = 32; o >= 1; o >>= 1) ss += __shfl_xor(ss, o);
        if (lane < 32) ssq[(size_t)row * 32 + lane] = lane == 0 ? ss : 0.f;
    }
}

__device__ void im2col_phase(const bf16_t* __restrict__ P, const float* __restrict__ posk, const float* __restrict__ posv, bf16_t* __restrict__ AKV, float* __restrict__ HPRE) {
    const int nth = opaque_gx() * 512;
    for (int i = opaque_bx() * 512 + opaque_tid(); i < 2 * 16 * 128 * 32 * 16; i += nth) {
        const int c8 = i & 15, l = (i >> 4) & 31, n = (i >> 9) & 127, bg = (i >> 16) & 15, kv = i >> 20, b = bg >> 1, g = bg & 1;
        u32x4 w = {0u, 0u, 0u, 0u};
        if (n < 127) {
            const u32x4 s = *(const u32x4*)(P + (size_t)(b * TSEQ + 16 * n + l) * LDP + (kv ? 1280 : 1024) + g * 128 + c8 * 8);
            const float* pp = (kv ? posv : posk) + l * 128 + c8 * 8; const f32x4 p0 = *(const f32x4*)pp, p1 = *(const f32x4*)(pp + 4);
            w.x = cvtpk2(bf_lo(s.x) + p0[0], bf_hi(s.x) + p0[1]); w.y = cvtpk2(bf_lo(s.y) + p0[2], bf_hi(s.y) + p0[3]);
            w.z = cvtpk2(bf_lo(s.z) + p1[0], bf_hi(s.z) + p1[1]); w.w = cvtpk2(bf_lo(s.w) + p1[2], bf_hi(s.w) + p1[3]);
        }
        *(u32x4*)(AKV + (size_t)(kv * 2048 + bg * 128 + n) * 4096 + l * 128 + c8 * 8) = w;
    }
}

__device__ void hconv_phase(const float* __restrict__ HPRE, bf16_t* __restrict__ HC) {
    const int nth = opaque_gx() * 512;
    for (int i = opaque_bx() * 512 + opaque_tid(); i < 2048 * 512 / 8; i += nth) {
        f32x4 a = *(const f32x4*)(HPRE + (size_t)i * 8), b = *(const f32x4*)(HPRE + (size_t)i * 8 + 4); f32x4 x, y;
#pragma unroll
        for (int sl = 1; sl < 8; ++sl) { a += *(const f32x4*)(HPRE + (size_t)sl * (2048 * 512) + (size_t)i * 8); b += *(const f32x4*)(HPRE + (size_t)sl * (2048 * 512) + (size_t)i * 8 + 4); }
#pragma unroll
        for (int j = 0; j < 4; ++j) { x[j] = a[j] * __builtin_amdgcn_rcpf(1.0f + __builtin_amdgcn_exp2f(-1.4426950408889634f * a[j])); y[j] = b[j] * __builtin_amdgcn_rcpf(1.0f + __builtin_amdgcn_exp2f(-1.4426950408889634f * b[j])); }
        u32x4 w; w.x = cvtpk2(x[0], x[1]); w.y = cvtpk2(x[2], x[3]); w.z = cvtpk2(y[0], y[1]); w.w = cvtpk2(y[2], y[3]);
        *(u32x4*)(HC + (size_t)i * 8) = w;
    }
}

__device__ void cmp_mlp_phase(const bf16_t* __restrict__ P, const bf16_t* __restrict__ WC1, const bf16_t* __restrict__ WC2, const float* __restrict__ PT, bf16_t* __restrict__ KC, bf16_t* __restrict__ VCT, unsigned char* lds) {
    const int tid = opaque_tid(), wid = tid >> 6, lane = tid & 63, c = lane & 31, hi = lane >> 5;
    float* red = (float*)lds;
    for (int wgi = opaque_bx(); wgi < 64; wgi += opaque_gx()) {
        const int kv = wgi >> 5, bg = (wgi >> 1) & 15, sp = wgi & 1, b = bg >> 1, g = bg & 1;
        const int srow = tid >> 3, sch = (tid & 7) * 2, sn = sp * 64 + srow; const bool sval = sn < 127;
        const bf16_t* spp = P + (size_t)(b * TSEQ + 16 * (sval ? sn : 0)) * LDP + (kv ? 1280 : 1024) + g * 128 + sch * 8;
        const int sw0 = srow * 256 + ((sch ^ (srow & 15)) << 4), sw1 = srow * 256 + (((sch + 1) ^ (srow & 15)) << 4);
        const int rbase = c * 256, cx = c & 15;
        const bf16_t* w1p = WC1 + (size_t)(kv * 256 + 32 * wid + c) * 4096 + hi * 8;
        { float* ptl = (float*)(lds + 65536); const float* pq = PT + (size_t)kv * 64 * 256 + (size_t)((tid >> 8) * 32) * 256 + (tid & 255); float a = 0.f;
#pragma unroll
          for (int jx = 0; jx < 32; ++jx) a += pq[(size_t)jx * 256];
          ptl[tid] = a; }
        f32x16 h0 = f32x16{}, h1 = f32x16{};
        bf16x8 wA[8], wB[8]; u32x4 sa0 = {0u, 0u, 0u, 0u}, sa1 = {0u, 0u, 0u, 0u};
#define CM_LOADA(l_) do { if (sval) { sa0 = *(const u32x4*)(spp + (size_t)(l_) * LDP); sa1 = *(const u32x4*)(spp + (size_t)(l_) * LDP + 8); } } while (0)
#define CM_LOADW(W_, l_) do { _Pragma("unroll") for (int s8 = 0; s8 < 8; ++s8) W_[s8] = *(const bf16x8*)(w1p + (l_) * 128 + s8 * 16); } while (0)
#define CM_STA(buf_) do { *(u32x4*)(lds + (buf_) * 16384 + sw0) = sa0; *(u32x4*)(lds + (buf_) * 16384 + sw1) = sa1; } while (0)
#define CM_COMPUTE(buf_, W_) do { _Pragma("unroll") for (int s8 = 0; s8 < 8; ++s8) { const int off_ = (((s8 * 2 + hi) ^ cx) << 4); \
            const bf16x8 a0_ = *(const bf16x8*)(lds + (buf_) * 16384 + rbase + off_), a1_ = *(const bf16x8*)(lds + (buf_) * 16384 + 32 * 256 + rbase + off_); \
            h0 = __builtin_amdgcn_mfma_f32_32x32x16_bf16(W_[s8], a0_, h0, 0, 0, 0); h1 = __builtin_amdgcn_mfma_f32_32x32x16_bf16(W_[s8], a1_, h1, 0, 0, 0); } } while (0)
        CM_LOADA(0); CM_LOADW(wA, 0); CM_STA(0);
        __syncthreads();
        for (int l = 0; l < 32; l += 2) {
            CM_LOADA(l + 1); CM_LOADW(wB, l + 1);
            CM_COMPUTE(0, wA);
            CM_STA(1);
            __syncthreads();
            if (l + 2 < 32) { CM_LOADA(l + 2); CM_LOADW(wA, l + 2); }
            CM_COMPUTE(1, wB);
            if (l + 2 < 32) CM_STA(0);
            __syncthreads();
        }
#undef CM_LOADA
#undef CM_LOADW
#undef CM_STA
#undef CM_COMPUTE
        const float* ptp = (const float*)(lds + 65536) + 32 * wid + 4 * hi;
#pragma unroll
        for (int r = 0; r < 16; ++r) { const float pt = ptp[(r & 3) + 8 * (r >> 2)] + ptp[256 + (r & 3) + 8 * (r >> 2)]; float x0 = h0[r] + pt, x1 = h1[r] + pt;
            h0[r] = x0 * __builtin_amdgcn_rcpf(1.0f + __builtin_amdgcn_exp2f(-1.4426950408889634f * x0)); h1[r] = x1 * __builtin_amdgcn_rcpf(1.0f + __builtin_amdgcn_exp2f(-1.4426950408889634f * x1)); }
        bf16x8 pa[2][2];
#define CM_PK4(PV, B_, OUT) do { unsigned a0 = cvtpk2(PV[B_ + 0], PV[B_ + 1]), a1 = cvtpk2(PV[B_ + 2], PV[B_ + 3]), b0 = cvtpk2(PV[B_ + 4], PV[B_ + 5]), b1 = cvtpk2(PV[B_ + 6], PV[B_ + 7]); \
        auto r0 = __builtin_amdgcn_permlane32_swap(a0, b0, false, false); auto r1 = __builtin_amdgcn_permlane32_swap(a1, b1, false, false); \
        u32x4 w_ = {r0[0], r1[0], r0[1], r1[1]}; OUT = *reinterpret_cast<bf16x8*>(&w_); } while (0)
        CM_PK4(h0, 0, pa[0][0]); CM_PK4(h0, 8, pa[0][1]); CM_PK4(h1, 0, pa[1][0]); CM_PK4(h1, 8, pa[1][1]);
#undef CM_PK4
        bf16x8 w2[4][2];
#pragma unroll
        for (int dg = 0; dg < 4; ++dg)
#pragma unroll
            for (int u = 0; u < 2; ++u) w2[dg][u] = *(const bf16x8*)(WC2 + (size_t)(kv * 128 + 32 * dg + c) * 512 + kv * 256 + 32 * wid + 16 * u + 8 * hi);
#pragma unroll
        for (int st = 0; st < 2; ++st) {
#pragma unroll
            for (int dg = 0; dg < 4; ++dg) { f32x16 o = f32x16{};
#pragma unroll
                for (int u = 0; u < 2; ++u) o = kv ? __builtin_amdgcn_mfma_f32_32x32x16_bf16(pa[st][u], w2[dg][u], o, 0, 0, 0) : __builtin_amdgcn_mfma_f32_32x32x16_bf16(w2[dg][u], pa[st][u], o, 0, 0, 0);
#pragma unroll
                for (int r = 0; r < 16; ++r) red[(wid * 64 + dg * 16 + r) * 64 + lane] = o[r]; }
            __syncthreads();
            { const int dg = wid >> 1, rh = (wid & 1) * 8; float sm[8];
#pragma unroll
              for (int r = 0; r < 8; ++r) { float a = 0.f;
#pragma unroll
                  for (int q = 0; q < 8; ++q) a += red[(q * 64 + dg * 16 + rh + r) * 64 + lane];
                  sm[r] = a; }
              const int nb = (2 * sp + st) * 32;
#pragma unroll
              for (int gq = 0; gq < 2; ++gq) { u32x2 w; w.x = cvtpk2(sm[4 * gq], sm[4 * gq + 1]); w.y = cvtpk2(sm[4 * gq + 2], sm[4 * gq + 3]); const int o4 = 8 * ((rh >> 2) + gq) + 4 * hi;
                  if (kv == 0) *(u32x2*)(KC + ((size_t)bg * 128 + nb + c) * 128 + 32 * dg + o4) = w;
                  else *(u32x2*)(VCT + ((size_t)bg * 128 + 32 * dg + c) * 128 + nb + o4) = w; } }
            __syncthreads();
        }
    }
}

__device__ __forceinline__ int crow16(int r, int hi) { return (r & 3) + 8 * (r >> 2) + 4 * hi; }
__device__ void cmp_attn_phase(const bf16_t* __restrict__ P, const bf16_t* __restrict__ KC, const bf16_t* __restrict__ VCT, bf16_t* __restrict__ OCMP, unsigned* __restrict__ SELM, float* limp_all) {
    const int tid = opaque_tid(), wid = tid >> 6, lane = tid & 63, c = lane & 31, hi = lane >> 5;
    float* limp = limp_all + wid * 256;
    constexpr float C2 = 1.4426950408889634f * 0.08838834764831845f;
    const float NEGINF = -__builtin_inff();
    for (int item = opaque_bx() * 8 + wid; item < 4096; item += opaque_gx() * 8) {
        const int bg = item >> 8, tg = (bg & 8) ? 255 - (item & 255) : (item & 255), b = bg >> 1, g = bg & 1, t0 = tg * 8;
        const int tok = c & 7, hr = c >> 3, t = t0 + tok;
        const bf16_t* qp = P + (size_t)(b * TSEQ + t) * LDP + (g * 4 + hr) * 128 + hi * 8;
        bf16x8 qf[8];
#pragma unroll
        for (int ks = 0; ks < 8; ++ks) qf[ks] = *(const bf16x8*)(qp + ks * 16);
        const int nkg = (t0 + 7 >= 31) ? (((t0 + 7 - 31) >> 4) >> 5) + 1 : 0;
        const int nv = (t >= 31) ? ((t - 31) >> 4) : -1;
        const bf16_t* kcb = KC + (size_t)bg * 128 * 128; const bf16_t* vcb = VCT + (size_t)bg * 128 * 128;
        f32x16 s[4];
#pragma unroll
        for (int kg = 0; kg < 4; ++kg) { s[kg] = f32x16{};
            if (kg < nkg) {
#pragma unroll
                for (int ks = 0; ks < 8; ++ks) { const bf16x8 kf = *(const bf16x8*)(kcb + (size_t)(kg * 32 + c) * 128 + ks * 16 + hi * 8); s[kg] = __builtin_amdgcn_mfma_f32_32x32x16_bf16(kf, qf[ks], s[kg], 0, 0, 0); } } }
        float mx = NEGINF;
#pragma unroll
        for (int kg = 0; kg < 4; ++kg)
#pragma unroll
            for (int r = 0; r < 16; ++r) { const int n = kg * 32 + crow16(r, hi); const float x = (n <= nv) ? s[kg][r] * C2 : NEGINF; s[kg][r] = x; mx = fmaxf(mx, x); }
        mx = fmaxf(mx, __shfl_xor(mx, 32));
        if (mx == NEGINF) mx = 0.f;
        float sum = 0.f;
#pragma unroll
        for (int kg = 0; kg < 4; ++kg)
#pragma unroll
            for (int r = 0; r < 16; ++r) { const float e = __builtin_amdgcn_exp2f(s[kg][r] - mx); s[kg][r] = e; sum += e; }
        sum += __shfl_xor(sum, 32);
        const float inv = sum > 0.f ? 1.0f / sum : 0.f;
#pragma unroll
        for (int kg = 0; kg < 4; ++kg)
#pragma unroll
            for (int r = 0; r < 16; ++r) s[kg][r] *= inv;
        float av[16], rv[16];
#pragma unroll
        for (int f = 0; f < 16; ++f) { const int kg = f >> 2, q4 = (f & 3) * 4; const float bb = 0.5f * s[kg][q4 + 3]; av[f] = s[kg][q4] + s[kg][q4 + 1] + s[kg][q4 + 2] + bb; rv[f] = __shfl_xor(bb, 32); }
#pragma unroll
        for (int f = 0; f < 16; ++f) { float im = av[f] + (hi ? rv[f] : (f > 0 ? rv[f > 0 ? f - 1 : 0] : 0.f));
            im += __shfl_xor(im, 8); im += __shfl_xor(im, 16);
            if (c < 8) limp[tok * 32 + 2 * f + hi] = im; }
        bf16x8 pa[8];
#define CMP_PK4(PV, B_, OUT) do { unsigned a0 = cvtpk2(PV[B_ + 0], PV[B_ + 1]), a1 = cvtpk2(PV[B_ + 2], PV[B_ + 3]), b0 = cvtpk2(PV[B_ + 4], PV[B_ + 5]), b1 = cvtpk2(PV[B_ + 6], PV[B_ + 7]); \
        auto r0 = __builtin_amdgcn_permlane32_swap(a0, b0, false, false); auto r1 = __builtin_amdgcn_permlane32_swap(a1, b1, false, false); \
        u32x4 w_ = {r0[0], r1[0], r0[1], r1[1]}; OUT = *reinterpret_cast<bf16x8*>(&w_); } while (0)
#pragma unroll
        for (int kg = 0; kg < 4; ++kg) { CMP_PK4(s[kg], 0, pa[2 * kg]); CMP_PK4(s[kg], 8, pa[2 * kg + 1]); }
#undef CMP_PK4
        bf16_t* ob = OCMP + (size_t)(b * TSEQ + t0) * 1024 + g * 512;
#pragma unroll
        for (int d0 = 0; d0 < 4; ++d0) { f32x16 o = f32x16{};
#pragma unroll
            for (int u = 0; u < 8; ++u) if (u < 2 * nkg) { const bf16x8 vf = *(const bf16x8*)(vcb + (size_t)(d0 * 32 + c) * 128 + u * 16 + hi * 8); o = __builtin_amdgcn_mfma_f32_32x32x16_bf16(pa[u], vf, o, 0, 0, 0); }
#pragma unroll
            for (int r = 0; r < 16; ++r) { const int qrow = crow16(r, hi); const float v = o[r], vn = __shfl_xor(v, 1);
                if ((c & 1) == 0) *(unsigned*)(ob + (size_t)(qrow & 7) * 1024 + (qrow >> 3) * 128 + d0 * 32 + c) = cvtpk2(v, vn); } }
        asm volatile("s_waitcnt lgkmcnt(0)" ::: "memory");
        const int tk = lane & 7, sb = lane >> 3, tt = t0 + tk, cur = tt >> 6;
        unsigned mask;
        if (t0 < 1024) mask = (2u << cur) - 1u;
        else {
            float v[32];
#pragma unroll
            for (int sI = 0; sI < 32; ++sI) { float x = limp[tk * 32 + sI]; const bool forced = (sI == 0) | (sI == cur) | (sI == cur - 1); x = forced ? 1e4f : x; v[sI] = (sI <= cur) ? x : -1.f; }
            mask = 0u;
#pragma unroll
            for (int jx = 0; jx < 4; ++jx) { const int sI = sb * 4 + jx;
                float mine = v[0];
#pragma unroll
                for (int s2 = 1; s2 < 32; ++s2) mine = (s2 == sI) ? v[s2] : mine;
                int rank = 0;
#pragma unroll
                for (int s2 = 0; s2 < 32; ++s2) rank += (v[s2] > mine || (v[s2] == mine && s2 < sI)) ? 1 : 0;
                if (rank < 16 && mine >= 0.f) mask |= 1u << sI; }
            mask |= __shfl_xor(mask, 8); mask |= __shfl_xor(mask, 16); mask |= __shfl_xor(mask, 32);
        }
        if (lane < 8) SELM[bg * TSEQ + tt] = mask;
        asm volatile("s_waitcnt lgkmcnt(0)" ::: "memory");
    }
}

typedef att::BlockRef<att::bf16, att::bf16> ABlk;
__device__ void attn_build_items(int* items) {
    for (int i = opaque_bx() * 512 + opaque_tid(); i < 2048; i += opaque_gx() * 512) {
        int kind, j, qb;
        if (i < 960) { qb = 7 - i / 192; j = i % 192; kind = 0; }
        else if (i < 1536) { j = i - 960; if (j < 192) { kind = 0; qb = 2; } else { kind = 1; j -= 192; qb = 2 + (j >> 6); j &= 63; } }
        else if (i < 1792) { j = i - 1536; qb = 1; if (j < 192) kind = 0; else { kind = 1; j -= 192; } }
        else { j = i - 1792; qb = 0; if (j < 192) kind = 0; else { kind = 1; j -= 192; } }
        int b, qcol, kcol, vcol, ocol; size_t obuf; unsigned so = 0xffffffffu; int W = 1 << 20;
        if (kind == 1) { b = j >> 3; const int h = j & 7; qcol = h * 128; kcol = 2048 + (h >> 2) * 128; vcol = 2304 + (h >> 2) * 128; obuf = WS_OWIN; ocol = h * 128; W = 512; }
        else if (j >= 128) { j -= 128; b = j >> 3; const int h = j & 7; qcol = h * 128; kcol = 1536 + (h >> 2) * 128; vcol = 1792 + (h >> 2) * 128; obuf = WS_OSLC; ocol = h * 128;
            so = (unsigned)(WS_SELM + ((size_t)(b * 2 + (h >> 2)) * TSEQ + qb * 256) * 4); }
        else { b = j >> 4; const int hd = (j >> 2) & 3, cc = (j >> 1) & 1, vh = j & 1; qcol = 2560 + (hd * 2 + cc) * 128; kcol = 3584 + (hd * 2 + cc) * 128; vcol = 4608 + hd * 256 + vh * 128;
            obuf = cc ? WS_OD2 : WS_OD1; ocol = hd * 256 + vh * 128; }
        int* it = items + i * 8;
        it[0] = (int)(unsigned)(WS_ACT + ((size_t)(b * TSEQ + qb * 256) * LDP + qcol) * 2); it[1] = (int)(unsigned)(WS_ACT + ((size_t)(b * TSEQ) * LDP + kcol) * 2);
        it[2] = (int)(unsigned)(WS_ACT + ((size_t)(b * TSEQ) * LDP + vcol) * 2); it[3] = (int)(unsigned)(obuf + ((size_t)(b * TSEQ + qb * 256) * 1024 + ocol) * 2);
        it[4] = (int)so; it[5] = qb * 256; it[6] = W; it[7] = 0;
    }
}
__device__ __forceinline__ ABlk attn_item(const char* ws, const int* items, int i) {
    const int4 a = *(const int4*)(items + i * 8), b = *(const int4*)(items + i * 8 + 4);
    ABlk r; r.base = ws;
    r.qo = (unsigned)__builtin_amdgcn_readfirstlane(a.x); r.ko = (unsigned)__builtin_amdgcn_readfirstlane(a.y); r.vo = (unsigned)__builtin_amdgcn_readfirstlane(a.z); r.oo = (unsigned)__builtin_amdgcn_readfirstlane(a.w);
    r.so = (unsigned)__builtin_amdgcn_readfirstlane(b.x); r.P0 = __builtin_amdgcn_readfirstlane(b.y); r.W = __builtin_amdgcn_readfirstlane(b.z);
    return r;
}
__device__ void attn_phase(const char* ws, const int* items, char* lds) {
    const int G = opaque_gx(), wb = opaque_bx();
    const int w = (G == 256) ? (((wb & 7) << 2) | ((wb >> 3) & 3) | ((wb >> 5) << 5)) : wb;
    int rnd = 0;
    if (w >= 2048) return;
    ABlk cur = attn_item(ws, items, w);
    att::Seam<att::bf16> S;
    att::causal_swa_prime<att::bf16, att::bf16>(cur, lds, S);
    for (;;) {
        const int rn = rnd + 1; const int sn = rn * G + ((rn & 1) ? G - 1 - w : w); const bool more = sn < 2048;
        const ABlk nxt = more ? attn_item(ws, items, sn) : cur;
        att::causal_swa_block<att::bf16, att::bf16>(cur, nxt, TSEQ, lds, S);
        if (!more) break;
        cur = nxt; rnd = rn;
    }
}

__device__ __forceinline__ void ld16bf(const bf16_t* p, float (&o)[16]) { const u32x4 a = *(const u32x4*)p, b = *(const u32x4*)(p + 8);
    o[0] = bf_lo(a.x); o[1] = bf_hi(a.x); o[2] = bf_lo(a.y); o[3] = bf_hi(a.y); o[4] = bf_lo(a.z); o[5] = bf_hi(a.z); o[6] = bf_lo(a.w); o[7] = bf_hi(a.w);
    o[8] = bf_lo(b.x); o[9] = bf_hi(b.x); o[10] = bf_lo(b.y); o[11] = bf_hi(b.y); o[12] = bf_lo(b.z); o[13] = bf_hi(b.z); o[14] = bf_lo(b.w); o[15] = bf_hi(b.w); }
__device__ __forceinline__ void st16bf(bf16_t* p, const float (&v)[16]) { u32x4 a, b; a.x = cvtpk2(v[0], v[1]); a.y = cvtpk2(v[2], v[3]); a.z = cvtpk2(v[4], v[5]); a.w = cvtpk2(v[6], v[7]);
    b.x = cvtpk2(v[8], v[9]); b.y = cvtpk2(v[10], v[11]); b.z = cvtpk2(v[12], v[13]); b.w = cvtpk2(v[14], v[15]); *(u32x4*)p = a; *(u32x4*)(p + 8) = b; }
__device__ void combine_phase(KParamsPtr pp_, int l, const float* __restrict__ gates, const bf16_t* OCMP, const bf16_t* OSLC, const bf16_t* OWIN, const bf16_t* OD1, const bf16_t* OD2, bf16_t* HB) {
    const int tid_ = opaque_tid(); const int wid = tid_ >> 6, lane = tid_ & 63;
    const float* q1 = pp_->in[13] + l * 128; const float* k1 = pp_->in[14] + l * 128; const float* q2 = pp_->in[15] + l * 128; const float* k2 = pp_->in[16] + l * 128;
    float s1 = q1[lane] * k1[lane] + q1[lane + 64] * k1[lane + 64], s2 = q2[lane] * k2[lane] + q2[lane + 64] * k2[lane + 64];
#pragma unroll
    for (int o = 32; o >= 1; o >>= 1) { s1 += __shfl_xor(s1, o); s2 += __shfl_xor(s2, o); }
    const float lam_init = l == 0 ? 0.2f : 0.35550906759096926f;
    const float lam = expf(s1) - expf(s2) + lam_init;
    float sg[16]; { const float* sp = pp_->in[17] + l * 256 + (lane & 15) * 16;
#pragma unroll
        for (int j = 0; j < 16; ++j) sg[j] = sp[j] * (1.0f - lam_init); }
    for (int row = opaque_bx() * 8 + wid; row < M_TOK; row += opaque_gx() * 8) {
        { const int head = lane >> 3; const float* gp = gates + (size_t)row * 32 + head * 3; const float g0 = gp[0], g1 = gp[1], g2 = gp[2];
          float a[16], bq[16], cq[16]; const size_t off = (size_t)row * 1024 + lane * 16;
          ld16bf(OCMP + off, a); ld16bf(OSLC + off, bq); ld16bf(OWIN + off, cq);
#pragma unroll
          for (int j = 0; j < 16; ++j) a[j] = g0 * a[j] + g1 * bq[j] + g2 * cq[j];
          st16bf(HB + (size_t)row * DM + lane * 16, a); }
        { float a[16], bq[16]; const size_t off = (size_t)row * 1024 + lane * 16;
          ld16bf(OD1 + off, a); ld16bf(OD2 + off, bq); float ss = 0.f;
#pragma unroll
          for (int j = 0; j < 16; ++j) { a[j] = a[j] - lam * bq[j]; ss += a[j] * a[j]; }
          ss += __shfl_xor(ss, 1); ss += __shfl_xor(ss, 2); ss += __shfl_xor(ss, 4); ss += __shfl_xor(ss, 8);
          const float rstd = 1.0f / sqrtf(ss * (1.0f / 256.0f) + 1e-6f);
#pragma unroll
          for (int j = 0; j < 16; ++j) a[j] = a[j] * rstd * sg[j];
          st16bf(HB + (size_t)row * DM + 1024 + lane * 16, a); }
    }
}

__device__ void rstd_table(const float* __restrict__ ssq, PG8_LAS float* tab) {
    const int tid = opaque_tid(), bx = opaque_bx(), pm = 8 * (bx & 7) + ((bx >> 3) & 7);
    if (tid < 256) { const int row = pm * 256 + tid; const float* p = ssq + (size_t)row * 32; float sm = 0.f;
#pragma unroll
        for (int c4 = 0; c4 < 8; ++c4) { const f32x4 a = *(const f32x4*)(p + 4 * c4); sm += (a[0] + a[1]) + (a[2] + a[3]); }
        tab[row & 2047] = 1.0f / sqrtf(sm * (1.0f / 2048.0f) + 1e-6f); }
    __syncthreads();
}

#define XB_LAS __attribute__((address_space(3)))
#define XB_TMO      128
#define XB_XCNT(j)  (256  + 64 * (j))
#define XB_XSUB(j)  (1280 + 64 * (j))
#define XB_XGEN(j)  (2304 + 64 * (j))
#define XB_TOP      3328
#define XB_TOPGEN   3392
#define XCD_BAR_WORDS 3456
#define XB_SPIN_CAP (1u << 18)

__device__ __forceinline__ unsigned xb_ld(unsigned* p)              { return __hip_atomic_load(p, __ATOMIC_RELAXED, __HIP_MEMORY_SCOPE_AGENT); }
__device__ __forceinline__ unsigned xb_add(unsigned* p, unsigned v) { return __hip_atomic_fetch_add(p, v, __ATOMIC_RELAXED, __HIP_MEMORY_SCOPE_AGENT); }
__device__ __forceinline__ unsigned xb_xcc_id() { return (unsigned)__builtin_amdgcn_s_getreg((3 << 11) | 20) & 0xFu; }
#define XB_SPIN(cond, bar) do { unsigned _sp = 0; while (cond) { __builtin_amdgcn_s_sleep(1); \
    if ((++_sp & 255u) == 0u) { if (xb_ld(&(bar)[XB_TMO])) break; if (_sp > XB_SPIN_CAP) { atomicAdd(&(bar)[XB_TMO], 1u); break; } } } } while (0)

struct XcdBarrier {
    unsigned* bar; unsigned x;
    volatile XB_LAS unsigned* st;
};

__device__ __forceinline__ XcdBarrier xcd_barrier_post(unsigned* bar, volatile XB_LAS unsigned* st) {
    XcdBarrier b; b.bar = bar; b.x = xb_xcc_id(); b.st = st;
    if (threadIdx.x == 0) (void)xb_add(&bar[XB_XCNT(b.x)], 1u);
    return b;
}
__device__ __forceinline__ void xcd_barrier_complete(unsigned* bar, unsigned x, unsigned& nloc, unsigned& nx) {
    const unsigned G = gridDim.x * gridDim.y * gridDim.z;
    unsigned sum, cnt, mine, sp = 0u;
    for (;;) {
        sum = 0u; cnt = 0u; mine = 0u;
#pragma unroll
        for (unsigned j = 0; j < 16; ++j) { const unsigned c = xb_ld(&bar[XB_XCNT(j)]); sum += c; cnt += (c > 0u) ? 1u : 0u; mine = (j == x) ? c : mine; }
        if (sum == G) break;
        __builtin_amdgcn_s_sleep(1);
        if ((++sp & 255u) == 0u) { if (xb_ld(&bar[XB_TMO])) break; if (sp > XB_SPIN_CAP) { atomicAdd(&bar[XB_TMO], 1u); break; } }
    }
    nloc = mine > 0u ? mine : 1u; nx = cnt > 0u ? cnt : 1u;
}

__device__ __forceinline__ void xcd_barrier(const XcdBarrier& b) {
    asm volatile("s_waitcnt vmcnt(0)" ::: "memory");
    __syncthreads();
    if (threadIdx.x == 0) {
        unsigned* bar = b.bar; unsigned bx_ = b.x; asm volatile("" : "+s"(bar), "+s"(bx_));
        __builtin_amdgcn_s_waitcnt(0);
        unsigned nloc = b.st[0], nx = b.st[1];
        if (nloc == 0u) { xcd_barrier_complete(bar, bx_, nloc, nx); b.st[0] = nloc; b.st[1] = nx; }
        const unsigned old = xb_add(&bar[XB_XSUB(bx_)], 1u);
        const unsigned gen = old / nloc;
        if (old + 1u == (gen + 1u) * nloc) {
            __builtin_amdgcn_fence(__ATOMIC_RELEASE, "agent");
            asm volatile("s_waitcnt vmcnt(0)" ::: "memory");
            const unsigned og = xb_add(&bar[XB_TOP], 1u);
            const unsigned tg = og / nx;
            if (og + 1u == (tg + 1u) * nx) xb_add(&bar[XB_TOPGEN], 1u);
            else XB_SPIN(xb_ld(&bar[XB_TOPGEN]) == tg, bar);
            __builtin_amdgcn_fence(__ATOMIC_ACQUIRE, "agent");
            xb_add(&bar[XB_XGEN(bx_)], 1u);
            asm volatile("s_waitcnt vmcnt(0)" ::: "memory");
        } else {
            XB_SPIN(xb_ld(&bar[XB_XGEN(bx_)]) == gen, bar);
            __builtin_amdgcn_fence(__ATOMIC_ACQUIRE, "agent");
            asm volatile("s_waitcnt vmcnt(0)" ::: "memory");
        }
    }
    __syncthreads();
}

constexpr int LDS_TOTAL = pg8::STAGE_BYTES + 64 + 8192;
__device__ __forceinline__ KParamsPtr kparams() { KParamsPtr q = (KParamsPtr)__builtin_amdgcn_kernarg_segment_ptr(); asm volatile("" : "+s"(q)); return q; }
#define WSP(T, off) ((T*)(pp->ws + (off)))
#define HBP ((bf16_t*)pp->out)
#define OCMPP ((bf16_t*)((char*)pp->out + (size_t)M_TOK * DM * 2))
#define HPREP ((float*)((char*)pp->out + (size_t)M_TOK * DM * 2 + SZ_O))
__global__ void __launch_bounds__(512) mega_fwd(Params p_unused) {
    extern __shared__ __attribute__((aligned(16))) unsigned char lds[];
    cg::grid_group grid = cg::this_grid();
    PG8_LAS unsigned char* glds = (PG8_LAS unsigned char*)lds; PG8_LAS float* rtab = (PG8_LAS float*)(glds + pg8::STAGE_BYTES + 64);
    if (threadIdx.x < 4) ((volatile XB_LAS unsigned*)(lds + pg8::STAGE_BYTES))[threadIdx.x] = 0u;
    __syncthreads();
    XcdBarrier xbar; { KParamsPtr pp = kparams(); xbar = xcd_barrier_post(WSP(unsigned, WS_BAR), (volatile XB_LAS unsigned*)(lds + pg8::STAGE_BYTES)); }
    { KParamsPtr pp = kparams(); prep_phase(pp, (float*)lds); attn_build_items(WSP(int, WS_ITEMS));
      xconv_phase(pp->in[0], HBP, WSP(float, WS_SSQ));
      if (pp->ws == nullptr) grid.sync(); }
    xcd_barrier(xbar);
    for (int ph = 0; ph < 20; ++ph) {
        const int l = ph >= 10 ? 1 : 0, q = ph - 10 * l;
        const bool first = (ph <= 1);
        if (q == 0 || q == 8) {
            KParamsPtr pp = kparams(); unsigned char* wl = pp->ws + (size_t)l * SZ_LAYER;
            rstd_table(WSP(const float, WS_SSQ), rtab);
            pg8::Gemm g{ph == 0 ? HBP : WSP(bf16_t, WS_XR), (const bf16_t*)(wl + (q == 0 ? OFF_W1A : OFF_W2A)), M_TOK, 2 * DFF, DM}; pg8::StaticOrder S; S.init(M_TOK, 2 * DFF, opaque_gx(), opaque_bx());
            pg8::EpiSwiGLU E{WSP(bf16_t, WS_ACT), DFF, rtab}; pg8::gemm_phase<pg8::EpiSwiGLU, pg8::StaticOrder, true, true>(glds, g, S, E, nullptr);
        } else if (q == 1 || q == 7 || q == 9) {
            KParamsPtr pp = kparams(); unsigned char* wl = pp->ws + (size_t)l * SZ_LAYER;
            pg8::Gemm gr; float rscale;
            if (q == 1) { gr = pg8::Gemm{WSP(bf16_t, WS_ACT), (const bf16_t*)(wl + OFF_W1D), M_TOK, DM, DFF}; rscale = 0.5f; }
            else if (q == 7) { gr = pg8::Gemm{HBP, (const bf16_t*)(wl + OFF_WOUT), M_TOK, DM, DM}; rscale = 1.0f; }
            else { gr = pg8::Gemm{WSP(bf16_t, WS_ACT), (const bf16_t*)(wl + OFF_W2D), M_TOK, DM, DFF}; rscale = 0.5f; }
            pg8::StaticOrder S; S.init(M_TOK, DM, opaque_gx(), opaque_bx()); pg8::EpiRes E{first ? pp->in[0] : (const float*)nullptr, WSP(bf16_t, WS_XR), DM, rscale, WSP(float, WS_SSQ)};
            pg8::gemm_phase<pg8::EpiRes, pg8::StaticOrder, true, true>(glds, gr, S, E, nullptr);
        } else if (q == 2) {
            KParamsPtr pp = kparams(); unsigned char* wl = pp->ws + (size_t)l * SZ_LAYER;
            rstd_table(WSP(const float, WS_SSQ), rtab);
            pg8::Gemm g{WSP(bf16_t, WS_XR), (const bf16_t*)(wl + OFF_WIN), M_TOK, NPROJ, DM}; pg8::StaticOrder S; S.init(M_TOK, NPROJ, opaque_gx(), opaque_bx());
            pg8::EpiProj E{WSP(bf16_t, WS_ACT), WSP(float, WS_GATES), WSP(const float, WS_ROPEC), WSP(const float, WS_ROPES), rtab}; pg8::gemm_phase<pg8::EpiProj, pg8::StaticOrder, true, true>(glds, g, S, E, nullptr);
        } else if (q == 3) {
            KParamsPtr pp = kparams(); unsigned char* wl = pp->ws + (size_t)l * SZ_LAYER;
            cmp_mlp_phase(WSP(const bf16_t, WS_ACT), (const bf16_t*)(wl + OFF_WC1), (const bf16_t*)(wl + OFF_WC2), WSP(const float, WS_PT) + (size_t)l * 2 * 64 * 256, WSP(bf16_t, WS_KC), WSP(bf16_t, WS_VCT), lds);
        } else if (q == 4) {
            KParamsPtr pp = kparams(); cmp_attn_phase(WSP(const bf16_t, WS_ACT), WSP(const bf16_t, WS_KC), WSP(const bf16_t, WS_VCT), OCMPP, WSP(unsigned, WS_SELM), (float*)lds);
        } else if (q == 5) {
            KParamsPtr pp = kparams(); attn_phase((const char*)pp->ws, WSP(const int, WS_ITEMS), (char*)lds);
        } else {
            KParamsPtr pp = kparams(); combine_phase(pp, l, WSP(const float, WS_GATES), (const bf16_t*)OCMPP, WSP(const bf16_t, WS_OSLC), WSP(const bf16_t, WS_OWIN), WSP(const bf16_t, WS_OD1), WSP(const bf16_t, WS_OD2), HBP);
        }
        xcd_barrier(xbar);
    }
    { KParamsPtr pp = kparams(); rmsnorm_phase<true, false>(WSP(const bf16_t, WS_XR), pp->in[23], nullptr, pp->out); }
}

extern "C" void kernel_launch(void* const* d_in, const int* in_sizes, int n_in, void* d_out, int out_size, void* d_ws, size_t ws_size, hipStream_t stream) {
    static int grid = 0;
    if (grid == 0) {
        if (n_in != 24 || in_sizes[0] != M_TOK * DM || out_size != M_TOK * DM || ws_size < WS_END) {
            fprintf(stderr, "kernel_launch: unexpected shapes (n_in %d, in0 %d, out %d, ws %zu need %zu)\n", n_in, n_in > 0 ? in_sizes[0] : -1, out_size, ws_size, (size_t)WS_END); grid = -1; return; }
        int dev = 0, cus = 0, per_cu = 0;
        (void)hipGetDevice(&dev); (void)hipDeviceGetAttribute(&cus, hipDeviceAttributeMultiprocessorCount, dev);
        if (hipFuncSetAttribute((const void*)mega_fwd, hipFuncAttributeMaxDynamicSharedMemorySize, LDS_TOTAL) != hipSuccess) { fprintf(stderr, "kernel_launch: hipFuncSetAttribute failed\n"); grid = -1; return; }
        if (hipOccupancyMaxActiveBlocksPerMultiprocessor(&per_cu, (const void*)mega_fwd, 512, LDS_TOTAL) != hipSuccess || per_cu < 1) { fprintf(stderr, "kernel_launch: occupancy query gave %d\n", per_cu); per_cu = 1; }
        (void)hipGetLastError();
        if (cus <= 0) cus = 256;
        grid = cus;
    }
    if (grid < 0) return;
    if (hipMemsetAsync((char*)d_ws + WS_BAR, 0, 16384, stream) != hipSuccess) { fprintf(stderr, "kernel_launch: memset of barrier words failed\n"); return; }
    Params p{};
    for (int i = 0; i < 24; ++i) p.in[i] = (const float*)d_in[i];
    p.out = (float*)d_out; p.ws = (unsigned char*)d_ws;
    void* args[] = {&p};
    hipError_t e = hipLaunchCooperativeKernel((const void*)mega_fwd, dim3(grid), dim3(512), args, LDS_TOTAL, stream);
    if (e != hipSuccess) fprintf(stderr, "kernel_launch: cooperative launch failed: %s (grid %d)\n", hipGetErrorString(e), grid);
}
```

```cpp
#include <hip/hip_runtime.h>
#include <hip/hip_bf16.h>
#include <hip/hip_cooperative_groups.h>
#include <cstdio>
#include <cstdint>
namespace cg = cooperative_groups;
#define PROBE_SYNC 0
#define PROBE_ATT 0
#define PROBE_PREP 0
#define PROBE_CMP 0
#define PROBE_NORM 0
#define PROBE_HOT 0
#define PROBE_EPI 0
#define PROBE_UP 0
#define PROBE_DOWN 0
__device__ __forceinline__ int opaque_bx() { int b = blockIdx.x; asm volatile("" : "+s"(b)); return b; }
__device__ __forceinline__ int opaque_gx() { int g = gridDim.x; asm volatile("" : "+s"(g)); return g; }
__device__ __forceinline__ int opaque_tid() { int t = threadIdx.x; asm volatile("" : "+v"(t)); return t; }

constexpr int M_TOK = 16384, DM = 2048, DFF = 5632, LDP = 5632, NPROJ = 5888, TSEQ = 2048;
__host__ __device__ constexpr bool is_rope_tile(int pn) { return pn <= 4 || pn == 6 || pn == 8 || (pn >= 10 && pn < 18); }

namespace pg8 {
#define PG8_LAS __attribute__((address_space(3)))
typedef unsigned short bf16_t;
typedef short bf16x8 __attribute__((ext_vector_type(8)));
typedef float f32x4 __attribute__((ext_vector_type(4)));
typedef unsigned u32x4 __attribute__((ext_vector_type(4)));
constexpr int BM = 256, BK = 64, HALF = 128, HTB = HALF * BK * 2  , STAGE_BYTES = 8 * HTB, NXCD = 8, WGM = 8;

__host__ __device__ __forceinline__ int lds_byte(int r, int c) { const int st = (r >> 4) * 2 + (c >> 5), rr = r & 15, cc = c & 31, ob = rr * 64 + cc * 2; return st * 1024 + (ob ^ (((ob >> 9) & 1) << 5)); }
__host__ __device__ __forceinline__ void stage_rc(int b, int& R, int& C) { const int st = b / 1024, sb = b % 1024, swz = sb ^ (((sb >> 9) & 1) << 5); R = (st >> 1) * 16 + swz / 64; C = (st & 1) * 32 + (swz % 64) / 2; }
__host__ __device__ __forceinline__ int perm32(int rho) { const int n = rho >> 4, i = rho & 15; return 8 * (i >> 2) + 4 * n + (i & 3); }

struct Unit { int pm, pn, ko = 0; };
struct Gemm { const bf16_t* A; const bf16_t* Bt; int M, N, K, Kl; };

struct StaticOrder {
    int nM, nN, nwg, G, c;
    __host__ __device__ void init(int M, int N, int G_, int c_) { nM = M / BM; nN = N / BM; nwg = nM * nN; G = G_; c = c_; }
    __host__ __device__ bool next(int i, Unit& u) const {
        const long L = (long)i * G + c; if (L >= nwg) return false;
        int wgid = (int)L; { const int q = nwg / NXCD, r = nwg % NXCD, xcd = wgid % NXCD, off = wgid / NXCD; wgid = (xcd < r ? xcd * (q + 1) : r * (q + 1) + (xcd - r) * q) + off; }
        const int nig = WGM * nN, gid = wgid / nig, fm = gid * WGM, gsz = (nM - fm) < WGM ? (nM - fm) : WGM;
        u.pm = fm + ((wgid % nig) % gsz); u.pn = (wgid % nig) / gsz; return true;
    }
    __device__ __forceinline__ void a_ready(const Unit&) const {}
    __device__ __forceinline__ void done(const Unit&) const {}
};
__device__ __forceinline__ unsigned cvt_pk_bf16(float lo, float hi) { unsigned r; asm volatile("v_cvt_pk_bf16_f32 %0, %1, %2" : "=v"(r) : "v"(lo), "v"(hi)); return r; }
typedef float f32x2 __attribute__((ext_vector_type(2)));
__device__ __forceinline__ float silu_f(float x) { return x * __builtin_amdgcn_rcpf(1.0f + __builtin_amdgcn_exp2f(-1.4426950408889634f * x)); }
__device__ __forceinline__ float sigmoid_f(float x) { return __builtin_amdgcn_rcpf(1.0f + __builtin_amdgcn_exp2f(-1.4426950408889634f * x)); }
__device__ __forceinline__ u32x4 pack8_bf16(f32x4 a, f32x4 b) { u32x4 w; w.x = cvt_pk_bf16(a[0], a[1]); w.y = cvt_pk_bf16(a[2], a[3]); w.z = cvt_pk_bf16(b[0], b[1]); w.w = cvt_pk_bf16(b[2], b[3]); return w; }

__device__ __forceinline__ void load_rstd(const PG8_LAS float* tab, int row0, float (&rs)[2][4]) {
#pragma unroll
    for (int ai = 0; ai < 2; ++ai)
#pragma unroll
        for (int m = 0; m < 4; ++m) rs[ai][m] = tab[(row0 + ai * HALF + m * 16) & 2047];
}
struct EpiSwiGLU {
    static constexpr bool PERM = true, AFTER_DRAIN = false;
    bf16_t* O; int ldc; const PG8_LAS float* rtab;
    __device__ __forceinline__ void operator()(const f32x4 (&acc)[2][2][4][2], const Unit& u, int wr, int wc, int fr, int fq) const {
        const int row0 = u.pm * BM + wr * 64 + fr, col0 = u.pn * 128 + wc * 32 + 8 * fq;
        float rs[2][4]; load_rstd(rtab, row0, rs);
        for (int rep_ = 0; rep_ < 1 + PROBE_EPI; ++rep_)
#pragma unroll
        for (int ai = 0; ai < 2; ++ai)
#pragma unroll
            for (int m = 0; m < 4; ++m) {
                asm volatile("" ::: "memory");
                bf16_t* rowp = O + (size_t)(row0 + ai * HALF + m * 16) * ldc + col0;
                f32x4 v0, v1;
#pragma unroll
                for (int j = 0; j < 4; ++j) { const float r_ = rs[ai][m]; v0[j] = silu_f(acc[ai][0][m][0][j] * r_) * (acc[ai][1][m][0][j] * r_); v1[j] = silu_f(acc[ai][0][m][1][j] * r_) * (acc[ai][1][m][1][j] * r_); }
                *(u32x4*)rowp = pack8_bf16(v0, v1);
            }
    }
};
struct EpiRes {
    static constexpr bool PERM = true, AFTER_DRAIN = false;
    const float* base32; bf16_t* xr; int ldc; float scale; float* ssq;
    __device__ __forceinline__ void operator()(const f32x4 (&acc)[2][2][4][2], const Unit& u, int wr, int wc, int fr, int fq) const {
        const int row0 = u.pm * BM + wr * 64 + fr, col0 = u.pn * BM + wc * 32 + 8 * fq;
        if (base32) {
#pragma unroll
            for (int ai = 0; ai < 2; ++ai) {
                f32x4 bv[4][2][2];
#pragma unroll
                for (int m = 0; m < 4; ++m) { const size_t off = (size_t)(row0 + ai * HALF + m * 16) * ldc + col0;
#pragma unroll
                    for (int bj = 0; bj < 2; ++bj)
#pragma unroll
                        for (int n = 0; n < 2; ++n) bv[m][bj][n] = *(const f32x4*)(base32 + off + bj * HALF + n * 4); }
#pragma unroll
                for (int m = 0; m < 4; ++m) { const size_t off = (size_t)(row0 + ai * HALF + m * 16) * ldc + col0; float ss = 0.f;
#pragma unroll
                    for (int bj = 0; bj < 2; ++bj) { const f32x4 x0 = bv[m][bj][0] + acc[ai][bj][m][0] * scale, x1 = bv[m][bj][1] + acc[ai][bj][m][1] * scale; *(u32x4*)(xr + off + bj * HALF) = pack8_bf16(x0, x1);
                        ss += ((x0[0] * x0[0] + x0[1] * x0[1]) + (x0[2] * x0[2] + x0[3] * x0[3])) + ((x1[0] * x1[0] + x1[1] * x1[1]) + (x1[2] * x1[2] + x1[3] * x1[3])); }
                    ss += __shfl_xor(ss, 16); ss += __shfl_xor(ss, 32); if (fq == 0) ssq[(size_t)(row0 + ai * HALF + m * 16) * 32 + u.pn * 4 + wc] = ss; }
                asm volatile("" ::: "memory");
            }
        } else {
            u32x4 bb[2][4][2];
#pragma unroll
            for (int ai = 0; ai < 2; ++ai)
#pragma unroll
                for (int m = 0; m < 4; ++m) { const size_t off = (size_t)(row0 + ai * HALF + m * 16) * ldc + col0;
#pragma unroll
                    for (int bj = 0; bj < 2; ++bj) bb[ai][m][bj] = *(const u32x4*)(xr + off + bj * HALF); }
#pragma unroll
            for (int ai = 0; ai < 2; ++ai)
#pragma unroll
                for (int m = 0; m < 4; ++m) { const size_t off = (size_t)(row0 + ai * HALF + m * 16) * ldc + col0; float ss = 0.f;
#pragma unroll
                    for (int bj = 0; bj < 2; ++bj) { const u32x4 w = bb[ai][m][bj];
                        const f32x4 b0 = {__uint_as_float(w.x << 16), __uint_as_float(w.x & 0xffff0000u), __uint_as_float(w.y << 16), __uint_as_float(w.y & 0xffff0000u)};
                        const f32x4 b1 = {__uint_as_float(w.z << 16), __uint_as_float(w.z & 0xffff0000u), __uint_as_float(w.w << 16), __uint_as_float(w.w & 0xffff0000u)};
                        const f32x4 x0 = b0 + acc[ai][bj][m][0] * scale, x1 = b1 + acc[ai][bj][m][1] * scale; *(u32x4*)(xr + off + bj * HALF) = pack8_bf16(x0, x1);
                        ss += ((x0[0] * x0[0] + x0[1] * x0[1]) + (x0[2] * x0[2] + x0[3] * x0[3])) + ((x1[0] * x1[0] + x1[1] * x1[1]) + (x1[2] * x1[2] + x1[3] * x1[3])); }
                    ss += __shfl_xor(ss, 16); ss += __shfl_xor(ss, 32); if (fq == 0) ssq[(size_t)(row0 + ai * HALF + m * 16) * 32 + u.pn * 4 + wc] = ss; }
        }
    }
};
struct EpiProj {
    static constexpr bool PERM = true, AFTER_DRAIN = false;
    bf16_t* P; float* gates; const float* rc; const float* rs; const PG8_LAS float* rtab;
    __device__ __forceinline__ void operator()(const f32x4 (&acc_)[2][2][4][2], const Unit& u, int wr, int wc, int fr, int fq) const {
        const int row0 = u.pm * BM + wr * 64 + fr, pn = u.pn;
        float rsd[2][4]; load_rstd(rtab, row0, rsd);
        if (pn == 22) {
            if (wc == 0 && fq < 3) {
#pragma unroll
                for (int ai = 0; ai < 2; ++ai)
#pragma unroll
                    for (int m = 0; m < 4; ++m) { float* gp = gates + (size_t)(row0 + ai * HALF + m * 16) * 32 + 8 * fq;
#pragma unroll
                        for (int n = 0; n < 2; ++n) { f32x4 v;
#pragma unroll
                            for (int j = 0; j < 4; ++j) v[j] = sigmoid_f(acc_[ai][0][m][n][j] * rsd[ai][m]);
                            *(f32x4*)(gp + 4 * n) = v; } }
            }
        } else if (is_rope_tile(pn)) {
            const int hp = wc >> 1, d0 = 32 * (wc & 1) + 8 * fq;
#pragma unroll
            for (int ai = 0; ai < 2; ++ai)
#pragma unroll
                for (int m = 0; m < 4; ++m) { const int row = row0 + ai * HALF + m * 16, t = row & (TSEQ - 1);
                    const f32x4 c0 = *(const f32x4*)(rc + t * 64 + d0), c1 = *(const f32x4*)(rc + t * 64 + d0 + 4), s0 = *(const f32x4*)(rs + t * 64 + d0), s1 = *(const f32x4*)(rs + t * 64 + d0 + 4);
                    const float rr_ = rsd[ai][m]; const f32x4 x1a = acc_[ai][0][m][0] * rr_, x1b = acc_[ai][0][m][1] * rr_, x2a = acc_[ai][1][m][0] * rr_, x2b = acc_[ai][1][m][1] * rr_;
                    const f32x4 o1a = x1a * c0 - x2a * s0, o1b = x1b * c1 - x2b * s1, o2a = x2a * c0 + x1a * s0, o2b = x2b * c1 + x1b * s1;
                    bf16_t* pp = P + (size_t)row * LDP + pn * 256 + hp * 128 + d0;
                    *(u32x4*)pp = pack8_bf16(o1a, o1b); *(u32x4*)(pp + 64) = pack8_bf16(o2a, o2b); }
        } else {
#pragma unroll
            for (int ai = 0; ai < 2; ++ai)
#pragma unroll
                for (int m = 0; m < 4; ++m) { bf16_t* pp = P + (size_t)(row0 + ai * HALF + m * 16) * LDP + pn * 256 + wc * 32 + 8 * fq;
#pragma unroll
                    for (int bj = 0; bj < 2; ++bj) *(u32x4*)(pp + bj * HALF) = pack8_bf16(acc_[ai][bj][m][0] * rsd[ai][m], acc_[ai][bj][m][1] * rsd[ai][m]); }
        }
    }
};
struct EpiSiluH {
    static constexpr bool PERM = true, AFTER_DRAIN = false;
    bf16_t* H;
    __device__ __forceinline__ void operator()(const f32x4 (&acc)[2][2][4][2], const Unit& u, int wr, int wc, int fr, int fq) const {
        const int row0 = u.pm * BM + wr * 64 + fr;
#pragma unroll
        for (int ai = 0; ai < 2; ++ai)
#pragma unroll
            for (int m = 0; m < 4; ++m) { bf16_t* pp = H + (size_t)((row0 + ai * HALF + m * 16) & 2047) * 512 + u.pn * 256 + wc * 32 + 8 * fq;
#pragma unroll
                for (int bj = 0; bj < 2; ++bj) { f32x4 v0, v1;
#pragma unroll
                    for (int j = 0; j < 4; ++j) { v0[j] = silu_f(acc[ai][bj][m][0][j]); v1[j] = silu_f(acc[ai][bj][m][1][j]); }
                    *(u32x4*)(pp + bj * HALF) = pack8_bf16(v0, v1); } }
    }
};
struct EpiKCVC {
    static constexpr bool PERM = true, AFTER_DRAIN = false;
    bf16_t* KC; bf16_t* VCT;
    __device__ __forceinline__ void operator()(const f32x4 (&acc)[2][2][4][2], const Unit& u, int wr, int wc, int fr, int fq) const {
        const int row0 = u.pm * BM + wr * 64 + fr, c0 = wc * 32 + 8 * fq;
#pragma unroll
        for (int ai = 0; ai < 2; ++ai)
#pragma unroll
            for (int m = 0; m < 4; ++m) { const int row = row0 + ai * HALF + m * 16, bg = row >> 7, n = row & 127;
                *(u32x4*)(KC + (size_t)row * 128 + c0) = pack8_bf16(acc[ai][0][m][0], acc[ai][0][m][1]);
#pragma unroll
                for (int nn = 0; nn < 2; ++nn)
#pragma unroll
                    for (int j = 0; j < 4; ++j) { const float v = acc[ai][1][m][nn][j]; VCT[((size_t)bg * 128 + c0 + 4 * nn + j) * 128 + n] = (bf16_t)(cvt_pk_bf16(v, v) & 0xffffu); } }
    }
};
struct EpiAtomicH {
    static constexpr bool PERM = false, AFTER_DRAIN = false;
    float* H;
    __device__ __forceinline__ void operator()(const f32x4 (&acc)[2][2][4][2], const Unit& u, int wr, int wc, int fr, int fq) const {
        const int row0 = u.pm * BM + wr * 64 + fr, col0 = u.pn * 256 + wc * 32 + 4 * fq; float* Hs = H + (size_t)(u.ko >> 10) * (2048 * 512);
#pragma unroll
        for (int ai = 0; ai < 2; ++ai)
#pragma unroll
            for (int m = 0; m < 4; ++m) { float* rp = Hs + (size_t)((row0 + ai * HALF + m * 16) & 2047) * 512 + col0;
#pragma unroll
                for (int bj = 0; bj < 2; ++bj)
#pragma unroll
                    for (int n = 0; n < 2; ++n) *(f32x4*)(rp + bj * HALF + n * 16) = acc[ai][bj][m][n]; }
    }
};
struct SplitOrder {
    int c;
    __device__ bool next(int i, Unit& u) const { if (i > 0 || c >= 128) return false; u.pm = c >> 3; u.pn = c >> 6; u.ko = (c & 7) * 512 * 2; return true; }
    __device__ __forceinline__ void a_ready(const Unit&) const {}
    __device__ __forceinline__ void done(const Unit&) const {}
};
struct HotOrder {
    int nwg, G, c;
    __device__ bool next(int i, Unit& u) const { const long L = (long)i * G + c; if (L >= nwg) return false; u.pm = 0; u.pn = c & 7; return true; }
    __device__ __forceinline__ void a_ready(const Unit&) const {}
    __device__ __forceinline__ void done(const Unit&) const {}
};
struct DiagOrder {
    int c;
    __device__ bool next(int i, Unit& u) const { if (i > 0 || c >= 16) return false; u.pm = c; u.pn = c >> 3; return true; }
    __device__ __forceinline__ void a_ready(const Unit&) const {}
    __device__ __forceinline__ void done(const Unit&) const {}
};
template <class Epi, class Sched, bool ALIGN_EPI = false, bool SP2 = false>
__device__ __forceinline__ void gemm_phase(PG8_LAS unsigned char* lds, const Gemm g, const Sched& S, const Epi& E, unsigned long long*  ) {
    const int tid = opaque_tid(), wid = __builtin_amdgcn_readfirstlane(tid >> 6), lane = tid & 63, wr = wid >> 2, wc = wid & 3, fr = lane & 15, fq = lane >> 4;
    const int K = g.K, nt = (g.Kl ? g.Kl : K) / BK;
    unsigned voffA[2], voffB[2];
#pragma unroll
    for (int i = 0; i < 2; ++i) { int R, C; stage_rc(tid * 16 + i * 8192, R, C); const int Rb = Epi::PERM ? ((R & ~31) + perm32(R & 31)) : R;
        voffA[i] = (unsigned)(R * K + C) * 2u; voffB[i] = (unsigned)(Rb * K + C) * 2u; }
    const size_t kstep = (size_t)(BK * 2);
    const size_t hstep = (size_t)HALF * K * 2;
    const size_t tstep = 2 * hstep;
    const unsigned ldsw = (unsigned)wid * 1024u;
    const int aoff = lds_byte(wr * 64 + fr, fq * 8), boff = lds_byte(wc * 32 + fr, fq * 8);
#define PG8_SA(b, h) (((b) * 2 + (h)) * HTB)
#define PG8_SB(b, h) ((4 + (b) * 2 + (h)) * HTB)
#define PG8_STAGE(bufoff, gbase, voff) do { _Pragma("unroll") for (int _i = 0; _i < 2; ++_i) \
        __builtin_amdgcn_global_load_lds((const unsigned*)((const char*)(gbase) + (voff)[_i]), (PG8_LAS unsigned*)(lds + (bufoff) + ldsw + _i * 8192), 16, 0, 0); } while (0)
#define PG8_LDA(dst, b, h) do { _Pragma("unroll") for (int m = 0; m < 4; ++m) _Pragma("unroll") for (int k = 0; k < 2; ++k) dst[m][k] = *(const PG8_LAS bf16x8*)(lds + PG8_SA(b, h) + aoff + m * 2048 + k * 1024); } while (0)
#define PG8_LDB(dst, b, h) do { _Pragma("unroll") for (int n = 0; n < 2; ++n) _Pragma("unroll") for (int k = 0; k < 2; ++k) dst[n][k] = *(const PG8_LAS bf16x8*)(lds + PG8_SB(b, h) + boff + n * 2048 + k * 1024); } while (0)
#define PG8_MMA(ai, bj, At, Bt) do { __builtin_amdgcn_s_setprio(1); _Pragma("unroll") for (int m = 0; m < 4; ++m) _Pragma("unroll") for (int n = 0; n < 2; ++n) _Pragma("unroll") for (int k = 0; k < 2; ++k) \
        acc[ai][bj][m][n] = __builtin_amdgcn_mfma_f32_16x16x32_bf16(Bt[n][k], At[m][k], acc[ai][bj][m][n], 0, 0, 0); __builtin_amdgcn_s_setprio(0); } while (0)
#define PG8_WAIT_V(n) asm volatile("s_waitcnt vmcnt(" #n ")" ::: "memory")
#define PG8_WAIT_L(n) asm volatile("s_waitcnt lgkmcnt(" #n ")" ::: "memory")
#define PG8_BAR __builtin_amdgcn_s_barrier()
#define PG8_SCHED __builtin_amdgcn_sched_barrier(0)
    Unit cur, nxt; int ui = 0;
    if (!S.next(0, cur)) return;
    f32x4 acc[2][2][4][2];
#pragma unroll
    for (int a = 0; a < 2; ++a)
#pragma unroll
        for (int b = 0; b < 2; ++b)
#pragma unroll
            for (int m = 0; m < 4; ++m)
#pragma unroll
                for (int n = 0; n < 2; ++n) acc[a][b][m][n] = (f32x4){0.f, 0.f, 0.f, 0.f};
    bf16x8 At[4][2], B0[2][2], B1[2][2];
    const char* cA = (const char*)g.A + (size_t)cur.pm * tstep + cur.ko; const char* cB = (const char*)g.Bt + (size_t)cur.pn * tstep + cur.ko;
    S.a_ready(cur);
    if constexpr (SP2) {
        PG8_STAGE(PG8_SB(0, 0), cB, voffB); PG8_STAGE(PG8_SB(0, 1), cB + hstep, voffB); PG8_STAGE(PG8_SA(0, 0), cA, voffA); PG8_STAGE(PG8_SA(0, 1), cA + hstep, voffA);
        if (wr == 1) PG8_BAR;
        PG8_WAIT_V(2); PG8_BAR;
        PG8_STAGE(PG8_SB(1, 0), cB + kstep, voffB); PG8_STAGE(PG8_SA(1, 0), cA + kstep, voffA); PG8_STAGE(PG8_SB(1, 1), cB + hstep + kstep, voffB);
        PG8_WAIT_V(6); PG8_BAR;
    } else {
        PG8_STAGE(PG8_SB(0, 0), cB, voffB); PG8_STAGE(PG8_SA(0, 0), cA, voffA); PG8_STAGE(PG8_SB(0, 1), cB + hstep, voffB); PG8_STAGE(PG8_SA(0, 1), cA + hstep, voffA);
        if (wr == 1) PG8_BAR;
        PG8_WAIT_V(4); PG8_BAR;
        PG8_STAGE(PG8_SB(1, 0), cB + kstep, voffB); PG8_STAGE(PG8_SA(1, 0), cA + kstep, voffA); PG8_STAGE(PG8_SB(1, 1), cB + hstep + kstep, voffB);
        PG8_WAIT_V(6); PG8_BAR;
    }
    for (;;) {
        const bool has_next = S.next(ui + 1, nxt);
        const char* nA = has_next ? (const char*)g.A + (size_t)nxt.pm * tstep + nxt.ko : cA; const char* nB = has_next ? (const char*)g.Bt + (size_t)nxt.pn * tstep + nxt.ko : cB;
        for (int t = 0; t < nt; t += 2) {
            const bool last = (t == nt - 2);
            const char* a1 = cA + (size_t)(t + 1) * kstep;
            const char* a2 = last ? nA : cA + (size_t)(t + 2) * kstep; const char* b2 = last ? nB : cB + (size_t)(t + 2) * kstep;
            const char* a3 = a2 + kstep; const char* b3 = b2 + kstep;
            if (last && has_next) S.a_ready(nxt);
            if constexpr (SP2) {
            PG8_LDB(B0, 0, 0); PG8_LDB(B1, 0, 1); PG8_SCHED; PG8_LDA(At, 0, 0); PG8_STAGE(PG8_SA(1, 1), a1 + hstep, voffA);
            PG8_WAIT_V(8); PG8_WAIT_L(0); PG8_BAR; PG8_MMA(0, 0, At, B0); PG8_MMA(0, 1, At, B1); PG8_BAR; PG8_SCHED;
            PG8_LDA(At, 0, 1); PG8_STAGE(PG8_SB(0, 0), b2, voffB); PG8_STAGE(PG8_SB(0, 1), b2 + hstep, voffB); PG8_STAGE(PG8_SA(0, 0), a2, voffA);
            PG8_WAIT_V(8); PG8_WAIT_L(0); PG8_BAR; PG8_MMA(1, 0, At, B0); PG8_MMA(1, 1, At, B1); PG8_BAR; PG8_SCHED;
            PG8_LDB(B0, 1, 0); PG8_LDB(B1, 1, 1); PG8_SCHED; PG8_LDA(At, 1, 0); PG8_STAGE(PG8_SA(0, 1), a2 + hstep, voffA);
            PG8_WAIT_V(8); PG8_WAIT_L(0); PG8_BAR; PG8_MMA(0, 0, At, B0); PG8_MMA(0, 1, At, B1); PG8_BAR; PG8_SCHED;
            PG8_LDA(At, 1, 1); PG8_STAGE(PG8_SB(1, 0), b3, voffB); PG8_STAGE(PG8_SB(1, 1), b3 + hstep, voffB); PG8_STAGE(PG8_SA(1, 0), a3, voffA);
            PG8_WAIT_V(8); PG8_WAIT_L(0); PG8_BAR; PG8_MMA(1, 0, At, B0); PG8_MMA(1, 1, At, B1); PG8_BAR; PG8_SCHED;
            } else {
            PG8_LDB(B0, 0, 0); PG8_SCHED; PG8_LDA(At, 0, 0); PG8_STAGE(PG8_SA(1, 1), a1 + hstep, voffA);
            PG8_WAIT_L(8); PG8_BAR; PG8_WAIT_L(0); PG8_MMA(0, 0, At, B0); PG8_BAR; PG8_SCHED;
            PG8_LDB(B1, 0, 1); PG8_STAGE(PG8_SB(0, 0), b2, voffB);
            PG8_BAR; PG8_WAIT_L(0); PG8_MMA(0, 1, At, B1); PG8_BAR;
            PG8_LDA(At, 0, 1); PG8_STAGE(PG8_SA(0, 0), a2, voffA);
            PG8_BAR; PG8_WAIT_L(0); PG8_MMA(1, 0, At, B0); PG8_BAR; PG8_SCHED;
            PG8_STAGE(PG8_SB(0, 1), b2 + hstep, voffB);
            PG8_WAIT_V(6); PG8_BAR; PG8_MMA(1, 1, At, B1); PG8_BAR;
            PG8_LDB(B0, 1, 0); PG8_SCHED; PG8_LDA(At, 1, 0); PG8_STAGE(PG8_SA(0, 1), a2 + hstep, voffA);
            PG8_WAIT_L(8); PG8_BAR; PG8_WAIT_L(0); PG8_MMA(0, 0, At, B0); PG8_BAR; PG8_SCHED;
            PG8_LDB(B1, 1, 1); PG8_STAGE(PG8_SB(1, 0), b3, voffB);
            PG8_BAR; PG8_WAIT_L(0); PG8_MMA(0, 1, At, B1); PG8_BAR;
            PG8_LDA(At, 1, 1); PG8_STAGE(PG8_SA(1, 0), a3, voffA);
            PG8_BAR; PG8_WAIT_L(0); PG8_MMA(1, 0, At, B0); PG8_BAR; PG8_SCHED;
            PG8_STAGE(PG8_SB(1, 1), b3 + hstep, voffB);
            PG8_WAIT_V(6); PG8_BAR; PG8_MMA(1, 1, At, B1); PG8_BAR;
            }
        }
        if constexpr (ALIGN_EPI) { if (wr == 0) PG8_BAR; }
        if constexpr (!Epi::AFTER_DRAIN) { E(acc, cur, wr, wc, fr, fq); S.done(cur); }
        if (!has_next) break;
#pragma unroll
        for (int a = 0; a < 2; ++a)
#pragma unroll
            for (int b = 0; b < 2; ++b)
#pragma unroll
                for (int m = 0; m < 4; ++m)
#pragma unroll
                    for (int n = 0; n < 2; ++n) acc[a][b][m][n] = (f32x4){0.f, 0.f, 0.f, 0.f};
        cur = nxt; cA = nA; cB = nB; ++ui;
        if constexpr (ALIGN_EPI) { if (wr == 1) PG8_BAR; }
    }
    PG8_WAIT_V(0);
    if constexpr (!ALIGN_EPI) { if (wr == 0) PG8_BAR; }
    PG8_BAR;
    if constexpr (Epi::AFTER_DRAIN) { E.fused(acc, cur, wr, wc, fr, fq, lds, wid, lane); S.done(cur); }
#undef PG8_SA
#undef PG8_SB
#undef PG8_STAGE
#undef PG8_LDA
#undef PG8_LDB
#undef PG8_MMA
#undef PG8_WAIT_V
#undef PG8_WAIT_L
#undef PG8_BAR
#undef PG8_SCHED
}
}
namespace att {
constexpr int D = 128; constexpr float THR = 8.f; constexpr bool WSKIP = false; constexpr int LDQ = LDP, LDK = LDP, LDO = 1024;
constexpr float SCALE = 0.08838834764831845f;
constexpr int NW = 8, QBLK = 32, KVBLK = 64, QB = NW * QBLK;
constexpr int SHM_V = KVBLK * D * 2, SHM_K = KVBLK * D * 2;
constexpr int LDS_BYTES = 2 * SHM_V + 2 * SHM_K + NW * 64 * 4;

using bf16 = __hip_bfloat16;
typedef short bf16x8 __attribute__((ext_vector_type(8)));
typedef short s16x4 __attribute__((ext_vector_type(4)));
typedef float f32x16 __attribute__((ext_vector_type(16)));
typedef float f32x4 __attribute__((ext_vector_type(4)));
typedef unsigned u32x4 __attribute__((ext_vector_type(4)));
template <class A, class Bt> struct same_t { static constexpr bool v = false; };
template <class A> struct same_t<A, A> { static constexpr bool v = true; };

#define KSWZ(row, colB) ((row) * 256 + ((colB) ^ (((row) & 7) << 4)))
#define SBAR() __builtin_amdgcn_sched_barrier(0)
__device__ __forceinline__ int v_st(int k, int c) { const int kk = (k & ~0xC) | ((k & 4) << 1) | ((k & 8) >> 1); return ((kk >> 3) * 4 + (c >> 5)) * 512 + ((kk & 7) * 32 + (c & 31)) * 2; }
__device__ __forceinline__ int v_rd_base(int lane) { return ((lane & 3) << 3) | (((lane >> 2) & 3) << 6) | (((lane >> 4) & 1) << 5) | (((lane >> 5) & 1) << 8); }
constexpr int v_rd_off(int d0, int ks, int half) { return d0 * 512 + ks * 4096 + half * 2048; }
__device__ __forceinline__ int crow(int r, int hi) { return (r & 3) + 8 * (r >> 2) + 4 * hi; }
__device__ __forceinline__ unsigned cvtpk(float lo, float hi) {
    unsigned r; asm volatile("v_cvt_pk_bf16_f32 %0, %1, %2" : "=v"(r) : "v"(lo), "v"(hi)); return r;
}
__device__ __forceinline__ bf16x8 pack8(f32x4 a, f32x4 b) {
    u32x4 w = {cvtpk(a[0], a[1]), cvtpk(a[2], a[3]), cvtpk(b[0], b[1]), cvtpk(b[2], b[3])};
    return *reinterpret_cast<bf16x8*>(&w);
}
template <class T> __device__ __forceinline__ bf16x8 load8(const T* p) {
    if constexpr (same_t<T, float>::v) { return pack8(*(const f32x4*)p, *(const f32x4*)(p + 4)); }
    else { return *reinterpret_cast<const bf16x8*>(p); }
}
__device__ __forceinline__ void mask_tile(f32x16& p0, f32x16& p1, int dq, unsigned W) {
    const float NEG = -__builtin_inff();
#pragma unroll
    for (int r = 0; r < 16; ++r) {
        const int c = (r & 3) + 8 * (r >> 2);
        if ((unsigned)(dq - c) >= W) p0[r] = NEG;
        if ((unsigned)(dq - c - 32) >= W) p1[r] = NEG;
    }
}
__device__ __forceinline__ void partialSM(f32x16& p0, f32x16& p1, float& m_reg, float& mn, float& alpha) {
    float pmax = p0[0]; for (int r = 1; r < 16; ++r) pmax = fmaxf(pmax, p0[r]); for (int r = 0; r < 16; ++r) pmax = fmaxf(pmax, p1[r]);
    { auto rr = __builtin_amdgcn_permlane32_swap(__float_as_uint(pmax), __float_as_uint(pmax), false, false);
      pmax = fmaxf(__uint_as_float(rr[0]), __uint_as_float(rr[1])); }
    constexpr float C2 = 1.4426950408889634f * SCALE;
    if (__builtin_expect(__all((pmax - m_reg) * SCALE <= THR), 1)) { mn = m_reg; alpha = 1.f; }
    else { mn = fmaxf(m_reg, pmax); alpha = __builtin_amdgcn_exp2f((m_reg - mn) * C2); m_reg = mn; }
    const float mnL = -mn * C2;
    for (int r = 0; r < 16; ++r) p0[r] = fmaf(p0[r], C2, mnL); for (int r = 0; r < 16; ++r) p1[r] = fmaf(p1[r], C2, mnL);
    for (int r = 0; r < 16; ++r) p0[r] = __builtin_amdgcn_exp2f(p0[r]);
}
__device__ __forceinline__ void finishSM(f32x16& p0, f32x16& p1, float alpha, float& l_reg, bf16x8& pa0, bf16x8& pa1, bf16x8& pa2, bf16x8& pa3) {
    for (int r = 0; r < 16; ++r) p1[r] = __builtin_amdgcn_exp2f(p1[r]);
    float ps = 0; for (int r = 0; r < 16; ++r) ps += p0[r]; for (int r = 0; r < 16; ++r) ps += p1[r];
    { auto rr = __builtin_amdgcn_permlane32_swap(__float_as_uint(ps), __float_as_uint(ps), false, false);
      ps = __uint_as_float(rr[0]) + __uint_as_float(rr[1]); }
    l_reg = l_reg * alpha + ps;
#define PK4(P, B_, OUT) do { unsigned a0 = cvtpk(P[B_+0], P[B_+1]), a1 = cvtpk(P[B_+2], P[B_+3]);                          \
        unsigned b0 = cvtpk(P[B_+4], P[B_+5]), b1 = cvtpk(P[B_+6], P[B_+7]);                                             \
        auto r0 = __builtin_amdgcn_permlane32_swap(a0, b0, false, false); auto r1 = __builtin_amdgcn_permlane32_swap(a1, b1, false, false); \
        u32x4 w = {r0[0], r1[0], r0[1], r1[1]}; OUT = *reinterpret_cast<bf16x8*>(&w); } while (0)
    PK4(p0, 0, pa0); PK4(p0, 8, pa1); PK4(p1, 0, pa2); PK4(p1, 8, pa3);
#undef PK4
}
template <int KB, bool SK>
__device__ __forceinline__ void qkt(f32x16& p0, f32x16& p1, const char* K_lds, int r32, int hi, const bf16x8* qr, bool act) {
    if (SK && !act) { const float NEG = -__builtin_inff();
#pragma unroll
        for (int r = 0; r < 16; ++r) { p0[r] = NEG; p1[r] = NEG; } return; }
    p0 = f32x16{}; p1 = f32x16{};
    const char* kb[4];
#pragma unroll
    for (int dd = 0; dd < 4; ++dd) kb[dd] = K_lds + KB * SHM_K + KSWZ(r32, (dd * 16 + hi * 8) * 2);
#pragma unroll
    for (int d0 = 0; d0 < 8; ++d0) { const char* a = kb[d0 & 3] + (d0 >> 2) * 128;
        bf16x8 b0 = *reinterpret_cast<const bf16x8*>(a);
        bf16x8 b1 = *reinterpret_cast<const bf16x8*>(a + 32 * 256);
        p0 = __builtin_amdgcn_mfma_f32_32x32x16_bf16(b0, qr[d0], p0, 0, 0, 0);
        p1 = __builtin_amdgcn_mfma_f32_32x32x16_bf16(b1, qr[d0], p1, 0, 0, 0); }
}
template <int VB, bool SK>
__device__ __forceinline__ void pv_tile(f32x16* o, int vb0, bf16x8 pa0, bf16x8 pa1, bf16x8 pa2, bf16x8 pa3, bool act) {
    if (SK && !act) return;
#define TRRD(dst, off) asm volatile("ds_read_b64_tr_b16 %0, %1 offset:%2" : "=&v"(dst) : "v"(vb0), "i"(off) : "memory")
#define PV_D0(d0) do { s16x4 l0, l1, l2, l3, h0, h1, h2, h3; constexpr int b_ = VB * SHM_V + v_rd_off(d0, 0, 0);     \
        TRRD(l0, b_); TRRD(h0, b_ + 2048); TRRD(l1, b_ + 4096); TRRD(h1, b_ + 6144); TRRD(l2, b_ + 8192); TRRD(h2, b_ + 10240); TRRD(l3, b_ + 12288); TRRD(h3, b_ + 14336); \
        asm volatile("s_waitcnt lgkmcnt(0)" ::: "memory"); SBAR();                 \
        o[d0] = __builtin_amdgcn_mfma_f32_32x32x16_bf16(pa0, (bf16x8){l0[0], l0[1], l0[2], l0[3], h0[0], h0[1], h0[2], h0[3]}, o[d0], 0, 0, 0);   \
        o[d0] = __builtin_amdgcn_mfma_f32_32x32x16_bf16(pa1, (bf16x8){l1[0], l1[1], l1[2], l1[3], h1[0], h1[1], h1[2], h1[3]}, o[d0], 0, 0, 0);   \
        o[d0] = __builtin_amdgcn_mfma_f32_32x32x16_bf16(pa2, (bf16x8){l2[0], l2[1], l2[2], l2[3], h2[0], h2[1], h2[2], h2[3]}, o[d0], 0, 0, 0);   \
        o[d0] = __builtin_amdgcn_mfma_f32_32x32x16_bf16(pa3, (bf16x8){l3[0], l3[1], l3[2], l3[3], h3[0], h3[1], h3[2], h3[3]}, o[d0], 0, 0, 0); } while (0)
    PV_D0(0); PV_D0(1); PV_D0(2); PV_D0(3);
#undef PV_D0
#undef TRRD
}

template <class TIn, class TOut> struct BlockRef { const char* base; unsigned qo, ko, vo, oo, so; int P0; int W;
    __device__ __forceinline__ const TIn* Qp() const { return (const TIn*)(base + qo); }
    __device__ __forceinline__ const TIn* Kp() const { return (const TIn*)(base + ko); }
    __device__ __forceinline__ const TIn* Vp() const { return (const TIn*)(base + vo); }
    __device__ __forceinline__ TOut* Op() const { return (TOut*)(base + oo); }
    __device__ __forceinline__ bool has_sel() const { return so != 0xffffffffu; }
    __device__ __forceinline__ const unsigned* selp() const { return (const unsigned*)(base + so); } };
template <class TIn> struct Seam {
    bf16x8 qr[8];
    bf16x8 st_v0, st_v1, st_k0, st_k1; f32x4 sf0, sf1, sf2, sf3;
    f32x4 tq[16];
};
__device__ __forceinline__ int swa_jlo(int P0, int W) { const int lowk = P0 - W + 1; return lowk > 0 ? lowk / KVBLK : 0; }
#define ROW(p, k0, rr) ((p) + (size_t)(k0) * LDK + (unsigned)((rr) * LDK + sc))
#define VMW() asm volatile("s_waitcnt vmcnt(0)" ::: "memory")
#define VMWN(n) asm volatile("s_waitcnt vmcnt(%0)" :: "i"(n) : "memory")
#define SLOAD_H(Kp, Vp, k0) do { S.st_v0 = load8<TIn>(ROW(Vp, k0, sr)); S.st_v1 = load8<TIn>(ROW(Vp, k0, 32 + sr));              \
                         S.st_k0 = load8<TIn>(ROW(Kp, k0, sr)); S.st_k1 = load8<TIn>(ROW(Kp, k0, 32 + sr)); } while (0)
#define SWRITE_HK(bf) do { *(bf16x8*)(K_lds + (bf) * SHM_K + kws) = S.st_k0; *(bf16x8*)(K_lds + (bf) * SHM_K + kws + 32 * 256) = S.st_k1; } while (0)
#define SWRITE_HV(bf) do { *(bf16x8*)(V_lds + (bf) * SHM_V + vst0) = S.st_v0; *(bf16x8*)(V_lds + (bf) * SHM_V + vst1) = S.st_v1; } while (0)
#define SWRITE_H(bf) do { SWRITE_HV(bf); SWRITE_HK(bf); } while (0)
#define SLOAD_F(p, k0) do { S.sf0 = *(const f32x4*)ROW(p, k0, sr); S.sf1 = *(const f32x4*)(ROW(p, k0, sr) + 4);                \
                            S.sf2 = *(const f32x4*)ROW(p, k0, 32 + sr); S.sf3 = *(const f32x4*)(ROW(p, k0, 32 + sr) + 4); } while (0)
#define SWRITE_KF(bf) do { *(bf16x8*)(K_lds + (bf) * SHM_K + kws) = pack8(S.sf0, S.sf1); *(bf16x8*)(K_lds + (bf) * SHM_K + kws + 32 * 256) = pack8(S.sf2, S.sf3); } while (0)
#define SWRITE_VF(bf) do { *(bf16x8*)(V_lds + (bf) * SHM_V + vst0) = pack8(S.sf0, S.sf1); *(bf16x8*)(V_lds + (bf) * SHM_V + vst1) = pack8(S.sf2, S.sf3); } while (0)
template <class TIn, class TOut>
__device__ __forceinline__ void causal_swa_prime(const BlockRef<TIn, TOut>& cur, char* lds, Seam<TIn>& S) {
    constexpr bool F32 = same_t<TIn, float>::v;
    const int tid = opaque_tid(), wid = __builtin_amdgcn_readfirstlane(tid >> 6), lane = tid & 63, r32 = lane & 31, hi = lane >> 5;
    const int sr = tid >> 4, sc = (tid & 15) * 8, kws = KSWZ(sr, sc * 2); char* K_lds = lds + 2 * SHM_V;
    const int kb0 = swa_jlo(cur.P0, cur.W) * KVBLK;
    for (int d0 = 0; d0 < 8; ++d0) S.qr[d0] = load8<TIn>(cur.Qp() + (size_t)(wid * QBLK) * LDQ + (unsigned)(r32 * LDQ + hi * 8) + d0 * 16);
    if constexpr (F32) { SLOAD_F((const float*)cur.Kp(), kb0); VMW(); SWRITE_KF(0); SBAR(); SLOAD_F((const float*)cur.Vp(), kb0); }
    else { SLOAD_H(cur.Kp(), cur.Vp(), kb0); VMW(); SWRITE_HK(0); }
    __syncthreads();
}
template <class TIn, class TOut>
__device__ __forceinline__ void causal_swa_block(const BlockRef<TIn, TOut>& cur, const BlockRef<TIn, TOut>& nxt, int skv, char* lds, Seam<TIn>& S) {
    constexpr bool F32 = same_t<TIn, float>::v;
    const int tid = opaque_tid(), wid = __builtin_amdgcn_readfirstlane(tid >> 6), lane = tid & 63, r32 = lane & 31, hi = lane >> 5;
    const int W = cur.W;
    const int j_lo = swa_jlo(cur.P0, W);
    const unsigned selw = cur.has_sel() ? cur.selp()[wid * QBLK + r32] : 0xffffffffu;
    int j_hi = (cur.P0 + QB - 1) / KVBLK + 1; if (j_hi > skv / KVBLK) j_hi = skv / KVBLK;
    const int NT = j_hi - j_lo;
    const int kbn = swa_jlo(nxt.P0, nxt.W) * KVBLK;
    const int qlo = cur.P0 + wid * QBLK, qm = qlo + r32 - 4 * hi;
    char* V_lds = lds; char* K_lds = lds + 2 * SHM_V;
    float* ws = (float*)(lds + 2 * SHM_V + 2 * SHM_K) + wid * 64; float* li_l = ws, * al_l = ws + 32;
    float m_reg = -1e30f, l_reg = 0; f32x16 o[4] = {};
    const int sr = tid >> 4, sc = (tid & 15) * 8, vst0 = v_st(sr, sc), vst1 = v_st(32 + sr, sc), kws = KSWZ(sr, sc * 2);
    const int vb0 = (int)(uintptr_t)V_lds + v_rd_base(lane);
    const TIn* Kh = cur.Kp(); const TIn* Vh = cur.Vp();
#define RESC(a) do { if (__any((a) < 1.f)) { if (hi == 0) al_l[r32] = (a); asm volatile("s_waitcnt lgkmcnt(0)" ::: "memory");              \
                     for (int d_ = 0; d_ < 4; ++d_) for (int r = 0; r < 16; ++r) o[d_][r] *= al_l[crow(r, hi)]; } } while (0)
#define KBASE(t) ((j_lo + (t)) * KVBLK)
#define ACT(t) (KBASE(t) <= qlo + QBLK - 1 && KBASE(t) + KVBLK - 1 >= qlo - W + 1)
#define MASKT(P0_, P1_, t) do { const int kb_ = KBASE(t); if ((!SK || ACT(t)) && (kb_ + KVBLK - 1 > qlo || kb_ <= qlo + QBLK - 1 - W)) mask_tile(P0_, P1_, qm - kb_, (unsigned)W); \
        if (cur.has_sel()) { if (!((selw >> (j_lo + (t))) & 1u)) { const float NEG_ = -__builtin_inff(); _Pragma("unroll") for (int r_ = 0; r_ < 16; ++r_) { P0_[r_] = NEG_; P1_[r_] = NEG_; } } } } while (0)
    constexpr int NQL = F32 ? 16 : 8;
    constexpr bool SK = WSKIP && !F32;
#define SEAM_K0() do { VMWN(NQL); if constexpr (F32) { SWRITE_KF(0); SBAR(); SLOAD_F((const float*)nxt.Vp(), kbn); } else { SWRITE_HK(0); } SBAR(); } while (0)
    f32x16 pA0, pA1, pB0, pB1; float mnA, mnB, alA, alB; bf16x8 pa0, pa1, pa2, pa3;
    if constexpr (F32) { VMW(); SWRITE_VF(0); SBAR(); } else { SWRITE_HV(0); SBAR(); }
    if (NT > 1) { if constexpr (F32) SLOAD_F((const float*)Kh, KBASE(1)); else SLOAD_H(Kh, Vh, KBASE(1)); }
    SBAR(); qkt<0, SK>(pA0, pA1, K_lds, r32, hi, S.qr, ACT(0));
    if constexpr (F32) { if (NT > 1) { VMW(); SWRITE_KF(1); SBAR(); SLOAD_F((const float*)Vh, KBASE(1)); } }
    MASKT(pA0, pA1, 0); partialSM(pA0, pA1, m_reg, mnA, alA);
    if (NT > 1) { VMW(); if constexpr (F32) { SWRITE_VF(1); SBAR(); if (NT > 2) SLOAD_F((const float*)Kh, KBASE(2)); } else SWRITE_H(1); }
    __syncthreads();
#define HALF_STEP(PX0, PX1, mnX, alX, PY0, PY1, alY, t, KB, VB, SB) do {                                                      \
        SBAR(); qkt<KB, SK>(PX0, PX1, K_lds, r32, hi, S.qr, ACT(t));                                             \
        finishSM(PY0, PY1, alY, l_reg, pa0, pa1, pa2, pa3); SBAR();                                                           \
        if ((t) + 1 < NT) { if constexpr (F32) { VMW(); SWRITE_KF(SB); SBAR(); SLOAD_F((const float*)Vh, KBASE((t) + 1)); }  \
                            else { SLOAD_H(Kh, Vh, KBASE((t) + 1)); } SBAR(); }                                               \
        pv_tile<VB, SK>(o, vb0, pa0, pa1, pa2, pa3, ACT((t) - 1)); MASKT(PX0, PX1, (t)); partialSM(PX0, PX1, m_reg, mnX, alX);                                        \
        __syncthreads();                                                                                                      \
        if ((t) + 1 < NT) { VMW(); if constexpr (F32) { SWRITE_VF(SB); SBAR(); if ((t) + 2 < NT) SLOAD_F((const float*)Kh, KBASE((t) + 2)); } \
                            else { SWRITE_H(SB); } }                                                                          \
        RESC(alX); __syncthreads(); } while (0)
    for (int t = 1; t + 1 < NT; t += 2) {
        HALF_STEP(pB0, pB1, mnB, alB, pA0, pA1, alA, t, 1, 0, 0);
        HALF_STEP(pA0, pA1, mnA, alA, pB0, pB1, alB, t + 1, 0, 1, 1);
    }
    const bool even = (NT & 1) == 0;
    if (even) { SBAR(); qkt<1, SK>(pB0, pB1, K_lds, r32, hi, S.qr, ACT(NT - 1)); SBAR(); }
#define QROW(e) (nxt.Qp() + (size_t)(wid * QBLK + r32) * LDQ + ((e) >> 1) * 16 + hi * 8 + ((e) & 1) * 4)
    if constexpr (F32) { SLOAD_F((const float*)nxt.Kp(), kbn); SBAR();
#pragma unroll
        for (int e = 0; e < 8; ++e) S.tq[e] = *(const f32x4*)QROW(e); }
    else { SLOAD_H(nxt.Kp(), nxt.Vp(), kbn); SBAR();
#pragma unroll
        for (int d0 = 0; d0 < 8; ++d0) S.qr[d0] = load8<TIn>(nxt.Qp() + (size_t)(wid * QBLK) * LDQ + (unsigned)(r32 * LDQ + hi * 8) + d0 * 16); }
    SBAR();
    finishSM(pA0, pA1, alA, l_reg, pa0, pa1, pa2, pa3); SBAR();
    if constexpr (F32) {
#pragma unroll
        for (int e = 8; e < 16; ++e) S.tq[e] = *(const f32x4*)QROW(e); SBAR(); }
#undef QROW
    pv_tile<0, SK>(o, vb0, pa0, pa1, pa2, pa3, ACT(even ? NT - 2 : NT - 1));
    if (even) { MASKT(pB0, pB1, NT - 1); partialSM(pB0, pB1, m_reg, mnB, alB); __syncthreads(); RESC(alB);
        finishSM(pB0, pB1, alB, l_reg, pa0, pa1, pa2, pa3); SBAR(); pv_tile<1, SK>(o, vb0, pa0, pa1, pa2, pa3, ACT(NT - 1)); }
    SBAR(); SEAM_K0();
    if (hi == 0) li_l[r32] = l_reg; asm volatile("s_waitcnt lgkmcnt(0)" ::: "memory");
    float rli[16];
#pragma unroll
    for (int r = 0; r < 16; ++r) rli[r] = __builtin_amdgcn_rcpf(li_l[crow(r, hi)]);
    TOut* Ow = cur.Op() + (size_t)(wid * QBLK) * LDO;
#pragma unroll
    for (int r = 0; r < 16; ++r) { const int orow = crow(r, hi);
#pragma unroll
        for (int d0 = 0; d0 < 4; ++d0) { const float v = o[d0][r] * rli[r];
            if constexpr (same_t<TOut, float>::v) { Ow[(size_t)orow * LDO + d0 * 32 + r32] = v; }
            else { const float vn = __shfl_xor(v, 1);
                   if ((r32 & 1) == 0) *(unsigned*)(Ow + (size_t)orow * LDO + d0 * 32 + r32) = cvtpk(v, vn); } } }
    if constexpr (F32) {
#pragma unroll
        for (int d0 = 0; d0 < 8; ++d0) S.qr[d0] = pack8(S.tq[2 * d0], S.tq[2 * d0 + 1]); }
    __syncthreads();
#undef RESC
#undef KBASE
#undef ACT
#undef MASKT
#undef SEAM_K0
#undef HALF_STEP
}
#undef ROW
#undef VMW
#undef VMWN
#undef SLOAD_H
#undef SWRITE_HK
#undef SWRITE_HV
#undef SWRITE_H
#undef SLOAD_F
#undef SWRITE_KF
#undef SWRITE_VF

}
typedef unsigned short bf16_t;
typedef short bf16x8 __attribute__((ext_vector_type(8)));
typedef float f32x4 __attribute__((ext_vector_type(4)));
typedef float f32x16 __attribute__((ext_vector_type(16)));
typedef unsigned u32x4 __attribute__((ext_vector_type(4)));
typedef unsigned u32x2 __attribute__((ext_vector_type(2)));
constexpr size_t SZ_WA = (size_t)11264 * 2048 * 2, SZ_WD = (size_t)2048 * 5632 * 2, SZ_WIN = (size_t)NPROJ * 2048 * 2, SZ_WOUT = (size_t)2048 * 2048 * 2,
                 SZ_WC1 = (size_t)512 * 4096 * 2, SZ_WC2 = (size_t)256 * 512 * 2;
constexpr size_t OFF_W1A = 0, OFF_W1D = OFF_W1A + SZ_WA, OFF_W2A = OFF_W1D + SZ_WD, OFF_W2D = OFF_W2A + SZ_WA, OFF_WIN = OFF_W2D + SZ_WD, OFF_WOUT = OFF_WIN + SZ_WIN,
                 OFF_WC1 = OFF_WOUT + SZ_WOUT, OFF_WC2 = OFF_WC1 + SZ_WC1, SZ_LAYER = OFF_WC2 + SZ_WC2;
constexpr size_t SZ_O = (size_t)M_TOK * 1024 * 2;
constexpr size_t WS_HB = 2 * SZ_LAYER, WS_XR = WS_HB  , WS_ACT = WS_HB + (size_t)M_TOK * DM * 2, WS_GATES = WS_ACT + (size_t)M_TOK * DFF * 2, WS_OCMP = WS_GATES + (size_t)M_TOK * 32 * 4,
                 WS_OSLC = WS_OCMP + SZ_O, WS_OWIN = WS_OSLC + SZ_O, WS_OD1 = WS_OWIN + SZ_O, WS_OD2 = WS_OD1 + SZ_O, WS_AKV = WS_OD1  ,
                 WS_HC = WS_OD2 + SZ_O, WS_KC = WS_HC + (size_t)2048 * 512 * 2, WS_VCT = WS_KC + (size_t)16 * 128 * 128 * 2, WS_SELM = WS_VCT + (size_t)16 * 128 * 128 * 2,
                 WS_ROPEC = WS_SELM + (size_t)16 * 2048 * 4, WS_ROPES = WS_ROPEC + (size_t)2048 * 64 * 4, WS_BAR = WS_ROPES + (size_t)2048 * 64 * 4, WS_ITEMS = WS_BAR + 16384, WS_HPRE = WS_ITEMS + (size_t)2048 * 8 * 4, WS_SSQ = WS_HPRE + (size_t)8 * 2048 * 512 * 4, WS_PT = WS_SSQ + (size_t)M_TOK * 32 * 4, WS_END = WS_PT + (size_t)4 * 64 * 256 * 4;
static_assert(SZ_LAYER % 256 == 0 && (size_t)4096 * 4096 * 2 == SZ_O, "layout");

struct Params { const float* in[24]; float* out; unsigned char* ws; };
typedef const __attribute__((address_space(4))) Params* KParamsPtr;

__device__ __forceinline__ unsigned cvtpk2(float lo, float hi) { unsigned r; asm volatile("v_cvt_pk_bf16_f32 %0, %1, %2" : "=v"(r) : "v"(lo), "v"(hi)); return r; }
__device__ __forceinline__ float bf_lo(unsigned w) { return __uint_as_float(w << 16); }
__device__ __forceinline__ float bf_hi(unsigned w) { return __uint_as_float(w & 0xffff0000u); }

__device__ __forceinline__ void tc_tile4(const float* __restrict__ src, int ld_src, int col0, int ncv, int ks0, bf16_t* __restrict__ dst, int ld_dst, int row0, int kd0, float* tile, const float* __restrict__ gk = nullptr) {
    const int tid = opaque_tid(), cc = tid & 63, kb = tid >> 6;
    float v[32];
    const bool ok = ks0 >= 0 && cc < ncv;
    const float* sp = src + (size_t)((ks0 >= 0 ? ks0 : 0) + kb) * ld_src + col0 + (cc < ncv ? cc : 0);
#pragma unroll
    for (int i = 0; i < 32; ++i) v[i] = ok ? sp[(size_t)(8 * i) * ld_src] : 0.f;
    if (gk && ks0 >= 0) {
#pragma unroll
        for (int i = 0; i < 32; ++i) v[i] *= gk[ks0 + kb + 8 * i]; }
#pragma unroll
    for (int i = 0; i < 32; ++i) tile[(kb + 8 * i) * 65 + cc] = v[i];
    __syncthreads();
    const int rr = tid >> 3, kq = (tid & 7) * 8;
#pragma unroll
    for (int jx = 0; jx < 4; ++jx) { const int k0 = kq + 64 * jx; u32x4 w;
        w.x = cvtpk2(tile[(k0 + 0) * 65 + rr], tile[(k0 + 1) * 65 + rr]); w.y = cvtpk2(tile[(k0 + 2) * 65 + rr], tile[(k0 + 3) * 65 + rr]);
        w.z = cvtpk2(tile[(k0 + 4) * 65 + rr], tile[(k0 + 5) * 65 + rr]); w.w = cvtpk2(tile[(k0 + 6) * 65 + rr], tile[(k0 + 7) * 65 + rr]);
        *(u32x4*)(dst + (size_t)(row0 + rr) * ld_dst + kd0 + k0) = w; }
    __syncthreads();
}
__device__ void prep_phase(KParamsPtr pp_, float* tile) {
    const int G = opaque_gx(), bx = opaque_bx();
    for (int l = 0; l < 2; ++l) {
        unsigned char* wl = pp_->ws + (size_t)l * SZ_LAYER;
        for (int f = 0; f < 2; ++f) {
            const float* gate = pp_->in[f ? 20 : 2] + (size_t)l * DM * DFF; const float* up = pp_->in[f ? 21 : 3] + (size_t)l * DM * DFF; const float* down = pp_->in[f ? 22 : 4] + (size_t)l * DM * DFF;
            bf16_t* dA = (bf16_t*)(wl + (f ? OFF_W2A : OFF_W1A)); bf16_t* dD = (bf16_t*)(wl + (f ? OFF_W2D : OFF_W1D)); const float* gn = pp_->in[f ? 19 : 1] + (size_t)l * DM;
            for (int tix = bx; tix < 176 * 8; tix += G) { const int rg = tix >> 3, kg = tix & 7, pp = rg >> 2, q = rg & 3;
                tc_tile4(q < 2 ? gate : up, DFF, 128 * pp + 64 * (q & 1), 64, kg * 256, dA, DM, rg * 64, kg * 256, tile, gn); }
            for (int tix = bx; tix < 32 * 22; tix += G) { const int rg = tix / 22, kg = tix - rg * 22;
                tc_tile4(down, DM, 64 * rg, 64, kg * 256, dD, DFF, rg * 64, kg * 256, tile); }
        }
        { const float* w = pp_->in[6] + (size_t)l * DM * 5656; bf16_t* dst = (bf16_t*)(wl + OFF_WIN); const float* gn = pp_->in[5] + (size_t)l * DM;
          for (int tix = bx; tix < 92 * 8; tix += G) { const int rg = tix >> 3, kg = tix & 7, pn = rg >> 2, q = rg & 3; int col0 = 0, ncv = 64, ks0 = kg * 256;
              if (pn == 22) { if (q == 0) { col0 = 2560; ncv = 24; } else ks0 = -1; }
              else { const int pcol = is_rope_tile(pn) ? 256 * pn + (q & 1) * 128 + 64 * (q >> 1) : 256 * pn + 64 * q; col0 = pcol < 2560 ? pcol : pcol + 24; }
              tc_tile4(w, 5656, col0, ncv, ks0, dst, DM, rg * 64, kg * 256, tile, gn); } }
        { const float* w = pp_->in[18] + (size_t)l * DM * DM; bf16_t* dst = (bf16_t*)(wl + OFF_WOUT);
          for (int tix = bx; tix < 32 * 8; tix += G) { const int rg = tix >> 3, kg = tix & 7; tc_tile4(w, DM, 64 * rg, 64, kg * 256, dst, DM, rg * 64, kg * 256, tile); } }
        { const float* wk = pp_->in[9] + (size_t)l * 4096 * 256; const float* wv = pp_->in[11] + (size_t)l * 4096 * 256; bf16_t* dst = (bf16_t*)(wl + OFF_WC1);
          for (int tix = bx; tix < 8 * 16; tix += G) { const int rg = tix >> 4, kg = tix & 15; tc_tile4(rg < 4 ? wk : wv, 256, 64 * (rg & 3), 64, kg * 256, dst, 4096, rg * 64, kg * 256, tile); } }
        { const float* wk = pp_->in[10] + (size_t)l * 256 * 128; const float* wv = pp_->in[12] + (size_t)l * 256 * 128; bf16_t* dst = (bf16_t*)(wl + OFF_WC2);
          for (int tix = bx; tix < 4 * 2; tix += G) { const int rg = tix >> 1, kg = tix & 1; const int ks0 = (rg < 2) == (kg == 0) ? 0 : -1;
              tc_tile4(rg < 2 ? wk : wv, 128, 64 * (rg & 1), 64, ks0, dst, 512, rg * 64, kg * 256, tile); } }
    }
    { float* PTP = (float*)(pp_->ws + WS_PT); const int tid_ = opaque_tid(), wv = tid_ >> 6, ln = tid_ & 63;
      if (wv < 4) for (int task = bx * 4 + wv; task < 1024; task += G * 4) { const int l = task >> 9, kv = (task >> 8) & 1, hg = (task >> 6) & 3, kc = task & 63;
          const float* pos = pp_->in[kv ? 8 : 7] + (size_t)l * 4096 + kc * 64; const float* w1 = pp_->in[kv ? 11 : 9] + (size_t)l * 4096 * 256 + (size_t)(kc * 64) * 256 + hg * 64 + ln; float a = 0.f;
#pragma unroll 16
          for (int i = 0; i < 64; ++i) a += pos[i] * w1[(size_t)i * 256];
          PTP[(size_t)((l * 2 + kv) * 64 + kc) * 256 + hg * 64 + ln] = a; } }
    float* rc = (float*)(pp_->ws + WS_ROPEC); float* rs = (float*)(pp_->ws + WS_ROPES);
    for (int i = bx * 512 + opaque_tid(); i < TSEQ * 64; i += G * 512) { const int t = i >> 6, d = i & 63;
        const float inv = __builtin_amdgcn_exp2f(-(float)d * 0.20762050593046014f);
        const float ang = (float)t * inv; float rev = ang * 0.15915494309189535f; rev -= floorf(rev);
        rc[i] = __builtin_amdgcn_cosf(rev); rs[i] = __builtin_amdgcn_sinf(rev); }
}

template <bool IN_BF16, bool TO_BF16>
__device__ void rmsnorm_phase(const void* __restrict__ xin, const float* __restrict__ g, bf16_t* __restrict__ ob, float* __restrict__ of) {
    const int tid_ = opaque_tid(); const int wid = tid_ >> 6, lane = tid_ & 63;
    f32x4 gv[8];
#pragma unroll
    for (int i = 0; i < 8; ++i) gv[i] = *(const f32x4*)(g + (lane + 64 * i) * 4);
    for (int row = opaque_bx() * 8 + wid; row < M_TOK; row += opaque_gx() * 8) {
        f32x4 v[8]; float ss = 0.f;
        if (IN_BF16) { const bf16_t* xr = (const bf16_t*)xin + (size_t)row * DM; u32x2 w[8];
#pragma unroll
            for (int i = 0; i < 8; ++i) w[i] = *(const u32x2*)(xr + (lane + 64 * i) * 4);
#pragma unroll
            for (int i = 0; i < 8; ++i) v[i] = (f32x4){bf_lo(w[i].x), bf_hi(w[i].x), bf_lo(w[i].y), bf_hi(w[i].y)}; }
        else { const float* xr = (const float*)xin + (size_t)row * DM;
#pragma unroll
            for (int i = 0; i < 8; ++i) v[i] = *(const f32x4*)(xr + (lane + 64 * i) * 4); }
#pragma unroll
        for (int i = 0; i < 8; ++i) ss += v[i][0] * v[i][0] + v[i][1] * v[i][1] + v[i][2] * v[i][2] + v[i][3] * v[i][3];
#pragma unroll
        for (int o = 32; o >= 1; o >>= 1) ss += __shfl_xor(ss, o);
        const float rstd = 1.0f / sqrtf(ss * (1.0f / DM) + 1e-6f);
#pragma unroll
        for (int i = 0; i < 8; ++i) { const f32x4 y = v[i] * rstd * gv[i];
            if (TO_BF16) { u32x2 w; w.x = cvtpk2(y[0], y[1]); w.y = cvtpk2(y[2], y[3]); *(u32x2*)(ob + (size_t)row * DM + (lane + 64 * i) * 4) = w; }
            else *(f32x4*)(of + (size_t)row * DM + (lane + 64 * i) * 4) = y; }
    }
}

__device__ void xconv_phase(const float* __restrict__ x, bf16_t* __restrict__ ob, float* __restrict__ ssq) {
    const int tid_ = opaque_tid(); const int wid = tid_ >> 6, lane = tid_ & 63;
    for (int row = opaque_bx() * 8 + wid; row < M_TOK; row += opaque_gx() * 8) {
        const float* xr = x + (size_t)row * DM; f32x4 v[8]; float ss = 0.f;
#pragma unroll
        for (int i = 0; i < 8; ++i) v[i] = *(const f32x4*)(xr + (lane + 64 * i) * 4);
#pragma unroll
        for (int i = 0; i < 8; ++i) { ss += v[i][0] * v[i][0] + v[i][1] * v[i][1] + v[i][2] * v[i][2] + v[i][3] * v[i][3];
            u32x2 w; w.x = cvtpk2(v[i][0], v[i][1]); w.y = cvtpk2(v[i][2], v[i][3]); *(u32x2*)(ob + (size_t)row * DM + (lane + 64 * i) * 4) = w; }
#pragma unroll
        for (int o = 32; o >= 1; o >>= 1) ss += __shfl_xor(ss, o);
        if (lane < 32) ssq[(size_t)row * 32 + lane] = lane == 0 ? ss : 0.f;
    }
}

__device__ void im2col_phase(const bf16_t* __restrict__ P, const float* __restrict__ posk, const float* __restrict__ posv, bf16_t* __restrict__ AKV, float* __restrict__ HPRE) {
    const int nth = opaque_gx() * 512;
    for (int i = opaque_bx() * 512 + opaque_tid(); i < 2 * 16 * 128 * 32 * 16; i += nth) {
        const int c8 = i & 15, l = (i >> 4) & 31, n = (i >> 9) & 127, bg = (i >> 16) & 15, kv = i >> 20, b = bg >> 1, g = bg & 1;
        u32x4 w = {0u, 0u, 0u, 0u};
        if (n < 127) {
            const u32x4 s = *(const u32x4*)(P + (size_t)(b * TSEQ + 16 * n + l) * LDP + (kv ? 1280 : 1024) + g * 128 + c8 * 8);
            const float* pp = (kv ? posv : posk) + l * 128 + c8 * 8; const f32x4 p0 = *(const f32x4*)pp, p1 = *(const f32x4*)(pp + 4);
            w.x = cvtpk2(bf_lo(s.x) + p0[0], bf_hi(s.x) + p0[1]); w.y = cvtpk2(bf_lo(s.y) + p0[2], bf_hi(s.y) + p0[3]);
            w.z = cvtpk2(bf_lo(s.z) + p1[0], bf_hi(s.z) + p1[1]); w.w = cvtpk2(bf_lo(s.w) + p1[2], bf_hi(s.w) + p1[3]);
        }
        *(u32x4*)(AKV + (size_t)(kv * 2048 + bg * 128 + n) * 4096 + l * 128 + c8 * 8) = w;
    }
}

__device__ void hconv_phase(const float* __restrict__ HPRE, bf16_t* __restrict__ HC) {
    const int nth = opaque_gx() * 512;
    for (int i = opaque_bx() * 512 + opaque_tid(); i < 2048 * 512 / 8; i += nth) {
        f32x4 a = *(const f32x4*)(HPRE + (size_t)i * 8), b = *(const f32x4*)(HPRE + (size_t)i * 8 + 4); f32x4 x, y;
#pragma unroll
        for (int sl = 1; sl < 8; ++sl) { a += *(const f32x4*)(HPRE + (size_t)sl * (2048 * 512) + (size_t)i * 8); b += *(const f32x4*)(HPRE + (size_t)sl * (2048 * 512) + (size_t)i * 8 + 4); }
#pragma unroll
        for (int j = 0; j < 4; ++j) { x[j] = a[j] * __builtin_amdgcn_rcpf(1.0f + __builtin_amdgcn_exp2f(-1.4426950408889634f * a[j])); y[j] = b[j] * __builtin_amdgcn_rcpf(1.0f + __builtin_amdgcn_exp2f(-1.4426950408889634f * b[j])); }
        u32x4 w; w.x = cvtpk2(x[0], x[1]); w.y = cvtpk2(x[2], x[3]); w.z = cvtpk2(y[0], y[1]); w.w = cvtpk2(y[2], y[3]);
        *(u32x4*)(HC + (size_t)i * 8) = w;
    }
}

__device__ void cmp_mlp_phase(const bf16_t* __restrict__ P, const bf16_t* __restrict__ WC1, const bf16_t* __restrict__ WC2, const float* __restrict__ PT, bf16_t* __restrict__ KC, bf16_t* __restrict__ VCT, unsigned char* lds) {
    const int tid = opaque_tid(), wid = tid >> 6, lane = tid & 63, c = lane & 31, hi = lane >> 5;
    float* red = (float*)lds;
    for (int wgi = opaque_bx(); wgi < 64; wgi += opaque_gx()) {
        const int kv = wgi >> 5, bg = (wgi >> 1) & 15, sp = wgi & 1, b = bg >> 1, g = bg & 1;
        const int srow = tid >> 3, sch = (tid & 7) * 2, sn = sp * 64 + srow; const bool sval = sn < 127;
        const bf16_t* spp = P + (size_t)(b * TSEQ + 16 * (sval ? sn : 0)) * LDP + (kv ? 1280 : 1024) + g * 128 + sch * 8;
        const int sw0 = srow * 256 + ((sch ^ (srow & 15)) << 4), sw1 = srow * 256 + (((sch + 1) ^ (srow & 15)) << 4);
        const int rbase = c * 256, cx = c & 15;
        const bf16_t* w1p = WC1 + (size_t)(kv * 256 + 32 * wid + c) * 4096 + hi * 8;
        { float* ptl = (float*)(lds + 65536); const float* pq = PT + (size_t)kv * 64 * 256 + (size_t)((tid >> 8) * 32) * 256 + (tid & 255); float a = 0.f;
#pragma unroll
          for (int jx = 0; jx < 32; ++jx) a += pq[(size_t)jx * 256];
          ptl[tid] = a; }
        f32x16 h0 = f32x16{}, h1 = f32x16{};
        bf16x8 wA[8], wB[8]; u32x4 sa0 = {0u, 0u, 0u, 0u}, sa1 = {0u, 0u, 0u, 0u};
#define CM_LOADA(l_) do { if (sval) { sa0 = *(const u32x4*)(spp + (size_t)(l_) * LDP); sa1 = *(const u32x4*)(spp + (size_t)(l_) * LDP + 8); } } while (0)
#define CM_LOADW(W_, l_) do { _Pragma("unroll") for (int s8 = 0; s8 < 8; ++s8) W_[s8] = *(const bf16x8*)(w1p + (l_) * 128 + s8 * 16); } while (0)
#define CM_STA(buf_) do { *(u32x4*)(lds + (buf_) * 16384 + sw0) = sa0; *(u32x4*)(lds + (buf_) * 16384 + sw1) = sa1; } while (0)
#define CM_COMPUTE(buf_, W_) do { _Pragma("unroll") for (int s8 = 0; s8 < 8; ++s8) { const int off_ = (((s8 * 2 + hi) ^ cx) << 4); \
            const bf16x8 a0_ = *(const bf16x8*)(lds + (buf_) * 16384 + rbase + off_), a1_ = *(const bf16x8*)(lds + (buf_) * 16384 + 32 * 256 + rbase + off_); \
            h0 = __builtin_amdgcn_mfma_f32_32x32x16_bf16(W_[s8], a0_, h0, 0, 0, 0); h1 = __builtin_amdgcn_mfma_f32_32x32x16_bf16(W_[s8], a1_, h1, 0, 0, 0); } } while (0)
        CM_LOADA(0); CM_LOADW(wA, 0); CM_STA(0);
        __syncthreads();
        for (int l = 0; l < 32; l += 2) {
            CM_LOADA(l + 1); CM_LOADW(wB, l + 1);
            CM_COMPUTE(0, wA);
            CM_STA(1);
            __syncthreads();
            if (l + 2 < 32) { CM_LOADA(l + 2); CM_LOADW(wA, l + 2); }
            CM_COMPUTE(1, wB);
            if (l + 2 < 32) CM_STA(0);
            __syncthreads();
        }
#undef CM_LOADA
#undef CM_LOADW
#undef CM_STA
#undef CM_COMPUTE
        const float* ptp = (const float*)(lds + 65536) + 32 * wid + 4 * hi;
#pragma unroll
        for (int r = 0; r < 16; ++r) { const float pt = ptp[(r & 3) + 8 * (r >> 2)] + ptp[256 + (r & 3) + 8 * (r >> 2)]; float x0 = h0[r] + pt, x1 = h1[r] + pt;
            h0[r] = x0 * __builtin_amdgcn_rcpf(1.0f + __builtin_amdgcn_exp2f(-1.4426950408889634f * x0)); h1[r] = x1 * __builtin_amdgcn_rcpf(1.0f + __builtin_amdgcn_exp2f(-1.4426950408889634f * x1)); }
        bf16x8 pa[2][2];
#define CM_PK4(PV, B_, OUT) do { unsigned a0 = cvtpk2(PV[B_ + 0], PV[B_ + 1]), a1 = cvtpk2(PV[B_ + 2], PV[B_ + 3]), b0 = cvtpk2(PV[B_ + 4], PV[B_ + 5]), b1 = cvtpk2(PV[B_ + 6], PV[B_ + 7]); \
        auto r0 = __builtin_amdgcn_permlane32_swap(a0, b0, false, false); auto r1 = __builtin_amdgcn_permlane32_swap(a1, b1, false, false); \
        u32x4 w_ = {r0[0], r1[0], r0[1], r1[1]}; OUT = *reinterpret_cast<bf16x8*>(&w_); } while (0)
        CM_PK4(h0, 0, pa[0][0]); CM_PK4(h0, 8, pa[0][1]); CM_PK4(h1, 0, pa[1][0]); CM_PK4(h1, 8, pa[1][1]);
#undef CM_PK4
        bf16x8 w2[4][2];
#pragma unroll
        for (int dg = 0; dg < 4; ++dg)
#pragma unroll
            for (int u = 0; u < 2; ++u) w2[dg][u] = *(const bf16x8*)(WC2 + (size_t)(kv * 128 + 32 * dg + c) * 512 + kv * 256 + 32 * wid + 16 * u + 8 * hi);
#pragma unroll
        for (int st = 0; st < 2; ++st) {
#pragma unroll
            for (int dg = 0; dg < 4; ++dg) { f32x16 o = f32x16{};
#pragma unroll
                for (int u = 0; u < 2; ++u) o = kv ? __builtin_amdgcn_mfma_f32_32x32x16_bf16(pa[st][u], w2[dg][u], o, 0, 0, 0) : __builtin_amdgcn_mfma_f32_32x32x16_bf16(w2[dg][u], pa[st][u], o, 0, 0, 0);
#pragma unroll
                for (int r = 0; r < 16; ++r) red[(wid * 64 + dg * 16 + r) * 64 + lane] = o[r]; }
            __syncthreads();
            { const int dg = wid >> 1, rh = (wid & 1) * 8; float sm[8];
#pragma unroll
              for (int r = 0; r < 8; ++r) { float a = 0.f;
#pragma unroll
                  for (int q = 0; q < 8; ++q) a += red[(q * 64 + dg * 16 + rh + r) * 64 + lane];
                  sm[r] = a; }
              const int nb = (2 * sp + st) * 32;
#pragma unroll
              for (int gq = 0; gq < 2; ++gq) { u32x2 w; w.x = cvtpk2(sm[4 * gq], sm[4 * gq + 1]); w.y = cvtpk2(sm[4 * gq + 2], sm[4 * gq + 3]); const int o4 = 8 * ((rh >> 2) + gq) + 4 * hi;
                  if (kv == 0) *(u32x2*)(KC + ((size_t)bg * 128 + nb + c) * 128 + 32 * dg + o4) = w;
                  else *(u32x2*)(VCT + ((size_t)bg * 128 + 32 * dg + c) * 128 + nb + o4) = w; } }
            __syncthreads();
        }
    }
}

__device__ __forceinline__ int crow16(int r, int hi) { return (r & 3) + 8 * (r >> 2) + 4 * hi; }
__device__ void cmp_attn_phase(const bf16_t* __restrict__ P, const bf16_t* __restrict__ KC, const bf16_t* __restrict__ VCT, bf16_t* __restrict__ OCMP, unsigned* __restrict__ SELM, float* limp_all) {
    const int tid = opaque_tid(), wid = tid >> 6, lane = tid & 63, c = lane & 31, hi = lane >> 5;
    float* limp = limp_all + wid * 256;
    constexpr float C2 = 1.4426950408889634f * 0.08838834764831845f;
    const float NEGINF = -__builtin_inff();
    for (int item = opaque_bx() * 8 + wid; item < 4096; item += opaque_gx() * 8) {
        const int bg = item >> 8, tg = (bg & 8) ? 255 - (item & 255) : (item & 255), b = bg >> 1, g = bg & 1, t0 = tg * 8;
        const int tok = c & 7, hr = c >> 3, t = t0 + tok;
        const bf16_t* qp = P + (size_t)(b * TSEQ + t) * LDP + (g * 4 + hr) * 128 + hi * 8;
        bf16x8 qf[8];
#pragma unroll
        for (int ks = 0; ks < 8; ++ks) qf[ks] = *(const bf16x8*)(qp + ks * 16);
        const int nkg = (t0 + 7 >= 31) ? (((t0 + 7 - 31) >> 4) >> 5) + 1 : 0;
        const int nv = (t >= 31) ? ((t - 31) >> 4) : -1;
        const bf16_t* kcb = KC + (size_t)bg * 128 * 128; const bf16_t* vcb = VCT + (size_t)bg * 128 * 128;
        f32x16 s[4];
#pragma unroll
        for (int kg = 0; kg < 4; ++kg) { s[kg] = f32x16{};
            if (kg < nkg) {
#pragma unroll
                for (int ks = 0; ks < 8; ++ks) { const bf16x8 kf = *(const bf16x8*)(kcb + (size_t)(kg * 32 + c) * 128 + ks * 16 + hi * 8); s[kg] = __builtin_amdgcn_mfma_f32_32x32x16_bf16(kf, qf[ks], s[kg], 0, 0, 0); } } }
        float mx = NEGINF;
#pragma unroll
        for (int kg = 0; kg < 4; ++kg)
#pragma unroll
            for (int r = 0; r < 16; ++r) { const int n = kg * 32 + crow16(r, hi); const float x = (n <= nv) ? s[kg][r] * C2 : NEGINF; s[kg][r] = x; mx = fmaxf(mx, x); }
        mx = fmaxf(mx, __shfl_xor(mx, 32));
        if (mx == NEGINF) mx = 0.f;
        float sum = 0.f;
#pragma unroll
        for (int kg = 0; kg < 4; ++kg)
#pragma unroll
            for (int r = 0; r < 16; ++r) { const float e = __builtin_amdgcn_exp2f(s[kg][r] - mx); s[kg][r] = e; sum += e; }
        sum += __shfl_xor(sum, 32);
        const float inv = sum > 0.f ? 1.0f / sum : 0.f;
#pragma unroll
        for (int kg = 0; kg < 4; ++kg)
#pragma unroll
            for (int r = 0; r < 16; ++r) s[kg][r] *= inv;
        float av[16], rv[16];
#pragma unroll
        for (int f = 0; f < 16; ++f) { const int kg = f >> 2, q4 = (f & 3) * 4; const float bb = 0.5f * s[kg][q4 + 3]; av[f] = s[kg][q4] + s[kg][q4 + 1] + s[kg][q4 + 2] + bb; rv[f] = __shfl_xor(bb, 32); }
#pragma unroll
        for (int f = 0; f < 16; ++f) { float im = av[f] + (hi ? rv[f] : (f > 0 ? rv[f > 0 ? f - 1 : 0] : 0.f));
            im += __shfl_xor(im, 8); im += __shfl_xor(im, 16);
            if (c < 8) limp[tok * 32 + 2 * f + hi] = im; }
        bf16x8 pa[8];
#define CMP_PK4(PV, B_, OUT) do { unsigned a0 = cvtpk2(PV[B_ + 0], PV[B_ + 1]), a1 = cvtpk2(PV[B_ + 2], PV[B_ + 3]), b0 = cvtpk2(PV[B_ + 4], PV[B_ + 5]), b1 = cvtpk2(PV[B_ + 6], PV[B_ + 7]); \
        auto r0 = __builtin_amdgcn_permlane32_swap(a0, b0, false, false); auto r1 = __builtin_amdgcn_permlane32_swap(a1, b1, false, false); \
        u32x4 w_ = {r0[0], r1[0], r0[1], r1[1]}; OUT = *reinterpret_cast<bf16x8*>(&w_); } while (0)
#pragma unroll
        for (int kg = 0; kg < 4; ++kg) { CMP_PK4(s[kg], 0, pa[2 * kg]); CMP_PK4(s[kg], 8, pa[2 * kg + 1]); }
#undef CMP_PK4
        bf16_t* ob = OCMP + (size_t)(b * TSEQ + t0) * 1024 + g * 512;
#pragma unroll
        for (int d0 = 0; d0 < 4; ++d0) { f32x16 o = f32x16{};
#pragma unroll
            for (int u = 0; u < 8; ++u) if (u < 2 * nkg) { const bf16x8 vf = *(const bf16x8*)(vcb + (size_t)(d0 * 32 + c) * 128 + u * 16 + hi * 8); o = __builtin_amdgcn_mfma_f32_32x32x16_bf16(pa[u], vf, o, 0, 0, 0); }
#pragma unroll
            for (int r = 0; r < 16; ++r) { const int qrow = crow16(r, hi); const float v = o[r], vn = __shfl_xor(v, 1);
                if ((c & 1) == 0) *(unsigned*)(ob + (size_t)(qrow & 7) * 1024 + (qrow >> 3) * 128 + d0 * 32 + c) = cvtpk2(v, vn); } }
        asm volatile("s_waitcnt lgkmcnt(0)" ::: "memory");
        const int tk = lane & 7, sb = lane >> 3, tt = t0 + tk, cur = tt >> 6;
        unsigned mask;
        if (t0 < 1024) mask = (2u << cur) - 1u;
        else {
            float v[32];
#pragma unroll
            for (int sI = 0; sI < 32; ++sI) { float x = limp[tk * 32 + sI]; const bool forced = (sI == 0) | (sI == cur) | (sI == cur - 1); x = forced ? 1e4f : x; v[sI] = (sI <= cur) ? x : -1.f; }
            mask = 0u;
#pragma unroll
            for (int jx = 0; jx < 4; ++jx) { const int sI = sb * 4 + jx;
                float mine = v[0];
#pragma unroll
                for (int s2 = 1; s2 < 32; ++s2) mine = (s2 == sI) ? v[s2] : mine;
                int rank = 0;
#pragma unroll
                for (int s2 = 0; s2 < 32; ++s2) rank += (v[s2] > mine || (v[s2] == mine && s2 < sI)) ? 1 : 0;
                if (rank < 16 && mine >= 0.f) mask |= 1u << sI; }
            mask |= __shfl_xor(mask, 8); mask |= __shfl_xor(mask, 16); mask |= __shfl_xor(mask, 32);
        }
        if (lane < 8) SELM[bg * TSEQ + tt] = mask;
        asm volatile("s_waitcnt lgkmcnt(0)" ::: "memory");
    }
}

typedef att::BlockRef<att::bf16, att::bf16> ABlk;
__device__ void attn_build_items(int* items) {
    for (int i = opaque_bx() * 512 + opaque_tid(); i < 2048; i += opaque_gx() * 512) {
        int kind, j, qb;
        if (i < 960) { qb = 7 - i / 192; j = i % 192; kind = 0; }
        else if (i < 1536) { j = i - 960; if (j < 192) { kind = 0; qb = 2; } else { kind = 1; j -= 192; qb = 2 + (j >> 6); j &= 63; } }
        else if (i < 1792) { j = i - 1536; qb = 1; if (j < 192) kind = 0; else { kind = 1; j -= 192; } }
        else { j = i - 1792; qb = 0; if (j < 192) kind = 0; else { kind = 1; j -= 192; } }
        int b, qcol, kcol, vcol, ocol; size_t obuf; unsigned so = 0xffffffffu; int W = 1 << 20;
        if (kind == 1) { b = j >> 3; const int h = j & 7; qcol = h * 128; kcol = 2048 + (h >> 2) * 128; vcol = 2304 + (h >> 2) * 128; obuf = WS_OWIN; ocol = h * 128; W = 512; }
        else if (j >= 128) { j -= 128; b = j >> 3; const int h = j & 7; qcol = h * 128; kcol = 1536 + (h >> 2) * 128; vcol = 1792 + (h >> 2) * 128; obuf = WS_OSLC; ocol = h * 128;
            so = (unsigned)(WS_SELM + ((size_t)(b * 2 + (h >> 2)) * TSEQ + qb * 256) * 4); }
        else { b = j >> 4; const int hd = (j >> 2) & 3, cc = (j >> 1) & 1, vh = j & 1; qcol = 2560 + (hd * 2 + cc) * 128; kcol = 3584 + (hd * 2 + cc) * 128; vcol = 4608 + hd * 256 + vh * 128;
            obuf = cc ? WS_OD2 : WS_OD1; ocol = hd * 256 + vh * 128; }
        int* it = items + i * 8;
        it[0] = (int)(unsigned)(WS_ACT + ((size_t)(b * TSEQ + qb * 256) * LDP + qcol) * 2); it[1] = (int)(unsigned)(WS_ACT + ((size_t)(b * TSEQ) * LDP + kcol) * 2);
        it[2] = (int)(unsigned)(WS_ACT + ((size_t)(b * TSEQ) * LDP + vcol) * 2); it[3] = (int)(unsigned)(obuf + ((size_t)(b * TSEQ + qb * 256) * 1024 + ocol) * 2);
        it[4] = (int)so; it[5] = qb * 256; it[6] = W; it[7] = 0;
    }
}
__device__ __forceinline__ ABlk attn_item(const char* ws, const int* items, int i) {
    const int4 a = *(const int4*)(items + i * 8), b = *(const int4*)(items + i * 8 + 4);
    ABlk r; r.base = ws;
    r.qo = (unsigned)__builtin_amdgcn_readfirstlane(a.x); r.ko = (unsigned)__builtin_amdgcn_readfirstlane(a.y); r.vo = (unsigned)__builtin_amdgcn_readfirstlane(a.z); r.oo = (unsigned)__builtin_amdgcn_readfirstlane(a.w);
    r.so = (unsigned)__builtin_amdgcn_readfirstlane(b.x); r.P0 = __builtin_amdgcn_readfirstlane(b.y); r.W = __builtin_amdgcn_readfirstlane(b.z);
    return r;
}
__device__ void attn_phase(const char* ws, const int* items, char* lds) {
    const int G = opaque_gx(), wb = opaque_bx();
    const int w = (G == 256) ? (((wb & 7) << 2) | ((wb >> 3) & 3) | ((wb >> 5) << 5)) : wb;
    int rnd = 0;
    if (w >= 2048) return;
    ABlk cur = attn_item(ws, items, w);
    att::Seam<att::bf16> S;
    att::causal_swa_prime<att::bf16, att::bf16>(cur, lds, S);
    for (;;) {
        const int rn = rnd + 1; const int sn = rn * G + ((rn & 1) ? G - 1 - w : w); const bool more = sn < 2048;
        const ABlk nxt = more ? attn_item(ws, items, sn) : cur;
        att::causal_swa_block<att::bf16, att::bf16>(cur, nxt, TSEQ, lds, S);
        if (!more) break;
        cur = nxt; rnd = rn;
    }
}

__device__ __forceinline__ void ld16bf(const bf16_t* p, float (&o)[16]) { const u32x4 a = *(const u32x4*)p, b = *(const u32x4*)(p + 8);
    o[0] = bf_lo(a.x); o[1] = bf_hi(a.x); o[2] = bf_lo(a.y); o[3] = bf_hi(a.y); o[4] = bf_lo(a.z); o[5] = bf_hi(a.z); o[6] = bf_lo(a.w); o[7] = bf_hi(a.w);
    o[8] = bf_lo(b.x); o[9] = bf_hi(b.x); o[10] = bf_lo(b.y); o[11] = bf_hi(b.y); o[12] = bf_lo(b.z); o[13] = bf_hi(b.z); o[14] = bf_lo(b.w); o[15] = bf_hi(b.w); }
__device__ __forceinline__ void st16bf(bf16_t* p, const float (&v)[16]) { u32x4 a, b; a.x = cvtpk2(v[0], v[1]); a.y = cvtpk2(v[2], v[3]); a.z = cvtpk2(v[4], v[5]); a.w = cvtpk2(v[6], v[7]);
    b.x = cvtpk2(v[8], v[9]); b.y = cvtpk2(v[10], v[11]); b.z = cvtpk2(v[12], v[13]); b.w = cvtpk2(v[14], v[15]); *(u32x4*)p = a; *(u32x4*)(p + 8) = b; }
__device__ void combine_phase(KParamsPtr pp_, int l, const float* __restrict__ gates, const bf16_t* OCMP, const bf16_t* OSLC, const bf16_t* OWIN, const bf16_t* OD1, const bf16_t* OD2, bf16_t* HB) {
    const int tid_ = opaque_tid(); const int wid = tid_ >> 6, lane = tid_ & 63;
    const float* q1 = pp_->in[13] + l * 128; const float* k1 = pp_->in[14] + l * 128; const float* q2 = pp_->in[15] + l * 128; const float* k2 = pp_->in[16] + l * 128;
    float s1 = q1[lane] * k1[lane] + q1[lane + 64] * k1[lane + 64], s2 = q2[lane] * k2[lane] + q2[lane + 64] * k2[lane + 64];
#pragma unroll
    for (int o = 32; o >= 1; o >>= 1) { s1 += __shfl_xor(s1, o); s2 += __shfl_xor(s2, o); }
    const float lam_init = l == 0 ? 0.2f : 0.35550906759096926f;
    const float lam = expf(s1) - expf(s2) + lam_init;
    float sg[16]; { const float* sp = pp_->in[17] + l * 256 + (lane & 15) * 16;
#pragma unroll
        for (int j = 0; j < 16; ++j) sg[j] = sp[j] * (1.0f - lam_init); }
    for (int row = opaque_bx() * 8 + wid; row < M_TOK; row += opaque_gx() * 8) {
        { const int head = lane >> 3; const float* gp = gates + (size_t)row * 32 + head * 3; const float g0 = gp[0], g1 = gp[1], g2 = gp[2];
          float a[16], bq[16], cq[16]; const size_t off = (size_t)row * 1024 + lane * 16;
          ld16bf(OCMP + off, a); ld16bf(OSLC + off, bq); ld16bf(OWIN + off, cq);
#pragma unroll
          for (int j = 0; j < 16; ++j) a[j] = g0 * a[j] + g1 * bq[j] + g2 * cq[j];
          st16bf(HB + (size_t)row * DM + lane * 16, a); }
        { float a[16], bq[16]; const size_t off = (size_t)row * 1024 + lane * 16;
          ld16bf(OD1 + off, a); ld16bf(OD2 + off, bq); float ss = 0.f;
#pragma unroll
          for (int j = 0; j < 16; ++j) { a[j] = a[j] - lam * bq[j]; ss += a[j] * a[j]; }
          ss += __shfl_xor(ss, 1); ss += __shfl_xor(ss, 2); ss += __shfl_xor(ss, 4); ss += __shfl_xor(ss, 8);
          const float rstd = 1.0f / sqrtf(ss * (1.0f / 256.0f) + 1e-6f);
#pragma unroll
          for (int j = 0; j < 16; ++j) a[j] = a[j] * rstd * sg[j];
          st16bf(HB + (size_t)row * DM + 1024 + lane * 16, a); }
    }
}

__device__ void rstd_table(const float* __restrict__ ssq, PG8_LAS float* tab) {
    const int tid = opaque_tid(), bx = opaque_bx(), pm = 8 * (bx & 7) + ((bx >> 3) & 7);
    if (tid < 256) { const int row = pm * 256 + tid; const float* p = ssq + (size_t)row * 32; float sm = 0.f;
#pragma unroll
        for (int c4 = 0; c4 < 8; ++c4) { const f32x4 a = *(const f32x4*)(p + 4 * c4); sm += (a[0] + a[1]) + (a[2] + a[3]); }
        tab[row & 2047] = 1.0f / sqrtf(sm * (1.0f / 2048.0f) + 1e-6f); }
    __syncthreads();
}

#define XB_LAS __attribute__((address_space(3)))
#define XB_TMO      128
#define XB_XCNT(j)  (256  + 64 * (j))
#define XB_XSUB(j)  (1280 + 64 * (j))
#define XB_XGEN(j)  (2304 + 64 * (j))
#define XB_TOP      3328
#define XB_TOPGEN   3392
#define XCD_BAR_WORDS 3456
#define XB_SPIN_CAP (1u << 18)

__device__ __forceinline__ unsigned xb_ld(unsigned* p)              { return __hip_atomic_load(p, __ATOMIC_RELAXED, __HIP_MEMORY_SCOPE_AGENT); }
__device__ __forceinline__ unsigned xb_add(unsigned* p, unsigned v) { return __hip_atomic_fetch_add(p, v, __ATOMIC_RELAXED, __HIP_MEMORY_SCOPE_AGENT); }
__device__ __forceinline__ unsigned xb_xcc_id() { return (unsigned)__builtin_amdgcn_s_getreg((3 << 11) | 20) & 0xFu; }
#define XB_SPIN(cond, bar) do { unsigned _sp = 0; while (cond) { __builtin_amdgcn_s_sleep(1); \
    if ((++_sp & 255u) == 0u) { if (xb_ld(&(bar)[XB_TMO])) break; if (_sp > XB_SPIN_CAP) { atomicAdd(&(bar)[XB_TMO], 1u); break; } } } } while (0)

struct XcdBarrier {
    unsigned* bar; unsigned x;
    volatile XB_LAS unsigned* st;
};

__device__ __forceinline__ XcdBarrier xcd_barrier_post(unsigned* bar, volatile XB_LAS unsigned* st) {
    XcdBarrier b; b.bar = bar; b.x = xb_xcc_id(); b.st = st;
    if (threadIdx.x == 0) (void)xb_add(&bar[XB_XCNT(b.x)], 1u);
    return b;
}
__device__ __forceinline__ void xcd_barrier_complete(unsigned* bar, unsigned x, unsigned& nloc, unsigned& nx) {
    const unsigned G = gridDim.x * gridDim.y * gridDim.z;
    unsigned sum, cnt, mine, sp = 0u;
    for (;;) {
        sum = 0u; cnt = 0u; mine = 0u;
#pragma unroll
        for (unsigned j = 0; j < 16; ++j) { const unsigned c = xb_ld(&bar[XB_XCNT(j)]); sum += c; cnt += (c > 0u) ? 1u : 0u; mine = (j == x) ? c : mine; }
        if (sum == G) break;
        __builtin_amdgcn_s_sleep(1);
        if ((++sp & 255u) == 0u) { if (xb_ld(&bar[XB_TMO])) break; if (sp > XB_SPIN_CAP) { atomicAdd(&bar[XB_TMO], 1u); break; } }
    }
    nloc = mine > 0u ? mine : 1u; nx = cnt > 0u ? cnt : 1u;
}

__device__ __forceinline__ void xcd_barrier(const XcdBarrier& b) {
    asm volatile("s_waitcnt vmcnt(0)" ::: "memory");
    __syncthreads();
    if (threadIdx.x == 0) {
        unsigned* bar = b.bar; unsigned bx_ = b.x; asm volatile("" : "+s"(bar), "+s"(bx_));
        __builtin_amdgcn_s_waitcnt(0);
        unsigned nloc = b.st[0], nx = b.st[1];
        if (nloc == 0u) { xcd_barrier_complete(bar, bx_, nloc, nx); b.st[0] = nloc; b.st[1] = nx; }
        const unsigned old = xb_add(&bar[XB_XSUB(bx_)], 1u);
        const unsigned gen = old / nloc;
        if (old + 1u == (gen + 1u) * nloc) {
            __builtin_amdgcn_fence(__ATOMIC_RELEASE, "agent");
            asm volatile("s_waitcnt vmcnt(0)" ::: "memory");
            const unsigned og = xb_add(&bar[XB_TOP], 1u);
            const unsigned tg = og / nx;
            if (og + 1u == (tg + 1u) * nx) xb_add(&bar[XB_TOPGEN], 1u);
            else XB_SPIN(xb_ld(&bar[XB_TOPGEN]) == tg, bar);
            __builtin_amdgcn_fence(__ATOMIC_ACQUIRE, "agent");
            xb_add(&bar[XB_XGEN(bx_)], 1u);
            asm volatile("s_waitcnt vmcnt(0)" ::: "memory");
        } else {
            XB_SPIN(xb_ld(&bar[XB_XGEN(bx_)]) == gen, bar);
            __builtin_amdgcn_fence(__ATOMIC_ACQUIRE, "agent");
            asm volatile("s_waitcnt vmcnt(0)" ::: "memory");
        }
    }
    __syncthreads();
}

constexpr int LDS_TOTAL = pg8::STAGE_BYTES + 64 + 8192;
__device__ __forceinline__ KParamsPtr kparams() { KParamsPtr q = (KParamsPtr)__builtin_amdgcn_kernarg_segment_ptr(); asm volatile("" : "+s"(q)); return q; }
#define WSP(T, off) ((T*)(pp->ws + (off)))
#define HBP ((bf16_t*)pp->out)
#define OCMPP ((bf16_t*)((char*)pp->out + (size_t)M_TOK * DM * 2))
#define HPREP ((float*)((char*)pp->out + (size_t)M_TOK * DM * 2 + SZ_O))
__global__ void __launch_bounds__(512) mega_fwd(Params p_unused) {
    extern __shared__ __attribute__((aligned(16))) unsigned char lds[];
    cg::grid_group grid = cg::this_grid();
    PG8_LAS unsigned char* glds = (PG8_LAS unsigned char*)lds; PG8_LAS float* rtab = (PG8_LAS float*)(glds + pg8::STAGE_BYTES + 64);
    if (threadIdx.x < 4) ((volatile XB_LAS unsigned*)(lds + pg8::STAGE_BYTES))[threadIdx.x] = 0u;
    __syncthreads();
    XcdBarrier xbar; { KParamsPtr pp = kparams(); xbar = xcd_barrier_post(WSP(unsigned, WS_BAR), (volatile XB_LAS unsigned*)(lds + pg8::STAGE_BYTES)); }
    { KParamsPtr pp = kparams(); prep_phase(pp, (float*)lds); attn_build_items(WSP(int, WS_ITEMS));
      xconv_phase(pp->in[0], HBP, WSP(float, WS_SSQ));
      if (pp->ws == nullptr) grid.sync(); }
    xcd_barrier(xbar);
    for (int ph = 0; ph < 20; ++ph) {
        const int l = ph >= 10 ? 1 : 0, q = ph - 10 * l;
        const bool first = (ph <= 1);
        if (q == 0 || q == 8) {
            KParamsPtr pp = kparams(); unsigned char* wl = pp->ws + (size_t)l * SZ_LAYER;
            rstd_table(WSP(const float, WS_SSQ), rtab);
            pg8::Gemm g{ph == 0 ? HBP : WSP(bf16_t, WS_XR), (const bf16_t*)(wl + (q == 0 ? OFF_W1A : OFF_W2A)), M_TOK, 2 * DFF, DM}; pg8::StaticOrder S; S.init(M_TOK, 2 * DFF, opaque_gx(), opaque_bx());
            pg8::EpiSwiGLU E{WSP(bf16_t, WS_ACT), DFF, rtab}; pg8::gemm_phase<pg8::EpiSwiGLU, pg8::StaticOrder, true, true>(glds, g, S, E, nullptr);
        } else if (q == 1 || q == 7 || q == 9) {
            KParamsPtr pp = kparams(); unsigned char* wl = pp->ws + (size_t)l * SZ_LAYER;
            pg8::Gemm gr; float rscale;
            if (q == 1) { gr = pg8::Gemm{WSP(bf16_t, WS_ACT), (const bf16_t*)(wl + OFF_W1D), M_TOK, DM, DFF}; rscale = 0.5f; }
            else if (q == 7) { gr = pg8::Gemm{HBP, (const bf16_t*)(wl + OFF_WOUT), M_TOK, DM, DM}; rscale = 1.0f; }
            else { gr = pg8::Gemm{WSP(bf16_t, WS_ACT), (const bf16_t*)(wl + OFF_W2D), M_TOK, DM, DFF}; rscale = 0.5f; }
            pg8::StaticOrder S; S.init(M_TOK, DM, opaque_gx(), opaque_bx()); pg8::EpiRes E{first ? pp->in[0] : (const float*)nullptr, WSP(bf16_t, WS_XR), DM, rscale, WSP(float, WS_SSQ)};
            pg8::gemm_phase<pg8::EpiRes, pg8::StaticOrder, true, true>(glds, gr, S, E, nullptr);
        } else if (q == 2) {
            KParamsPtr pp = kparams(); unsigned char* wl = pp->ws + (size_t)l * SZ_LAYER;
            rstd_table(WSP(const float, WS_SSQ), rtab);
            pg8::Gemm g{WSP(bf16_t, WS_XR), (const bf16_t*)(wl + OFF_WIN), M_TOK, NPROJ, DM}; pg8::StaticOrder S; S.init(M_TOK, NPROJ, opaque_gx(), opaque_bx());
            pg8::EpiProj E{WSP(bf16_t, WS_ACT), WSP(float, WS_GATES), WSP(const float, WS_ROPEC), WSP(const float, WS_ROPES), rtab}; pg8::gemm_phase<pg8::EpiProj, pg8::StaticOrder, true, true>(glds, g, S, E, nullptr);
        } else if (q == 3) {
            KParamsPtr pp = kparams(); unsigned char* wl = pp->ws + (size_t)l * SZ_LAYER;
            cmp_mlp_phase(WSP(const bf16_t, WS_ACT), (const bf16_t*)(wl + OFF_WC1), (const bf16_t*)(wl + OFF_WC2), WSP(const float, WS_PT) + (size_t)l * 2 * 64 * 256, WSP(bf16_t, WS_KC), WSP(bf16_t, WS_VCT), lds);
        } else if (q == 4) {
            KParamsPtr pp = kparams(); cmp_attn_phase(WSP(const bf16_t, WS_ACT), WSP(const bf16_t, WS_KC), WSP(const bf16_t, WS_VCT), OCMPP, WSP(unsigned, WS_SELM), (float*)lds);
        } else if (q == 5) {
            KParamsPtr pp = kparams(); attn_phase((const char*)pp->ws, WSP(const int, WS_ITEMS), (char*)lds);
        } else {
            KParamsPtr pp = kparams(); combine_phase(pp, l, WSP(const float, WS_GATES), (const bf16_t*)OCMPP, WSP(const bf16_t, WS_OSLC), WSP(const bf16_t, WS_OWIN), WSP(const bf16_t, WS_OD1), WSP(const bf16_t, WS_OD2), HBP);
        }
        xcd_barrier(xbar);
    }
    { KParamsPtr pp = kparams(); rmsnorm_phase<true, false>(WSP(const bf16_t, WS_XR), pp->in[23], nullptr, pp->out); }
}

extern "C" void kernel_launch(void* const* d_in, const int* in_sizes, int n_in, void* d_out, int out_size, void* d_ws, size_t ws_size, hipStream_t stream) {
    static int grid = 0;
    if (grid == 0) {
        if (n_in != 24 || in_sizes[0] != M_TOK * DM || out_size != M_TOK * DM || ws_size < WS_END) {
            fprintf(stderr, "kernel_launch: unexpected shapes (n_in %d, in0 %d, out %d, ws %zu need %zu)\n", n_in, n_in > 0 ? in_sizes[0] : -1, out_size, ws_size, (size_t)WS_END); grid = -1; return; }
        int dev = 0, cus = 0, per_cu = 0;
        (void)hipGetDevice(&dev); (void)hipDeviceGetAttribute(&cus, hipDeviceAttributeMultiprocessorCount, dev);
        if (hipFuncSetAttribute((const void*)mega_fwd, hipFuncAttributeMaxDynamicSharedMemorySize, LDS_TOTAL) != hipSuccess) { fprintf(stderr, "kernel_launch: hipFuncSetAttribute failed\n"); grid = -1; return; }
        if (hipOccupancyMaxActiveBlocksPerMultiprocessor(&per_cu, (const void*)mega_fwd, 512, LDS_TOTAL) != hipSuccess || per_cu < 1) { fprintf(stderr, "kernel_launch: occupancy query gave %d\n", per_cu); per_cu = 1; }
        (void)hipGetLastError();
        if (cus <= 0) cus = 256;
        grid = cus;
    }
    if (grid < 0) return;
    if (hipMemsetAsync((char*)d_ws + WS_BAR, 0, 16384, stream) != hipSuccess) { fprintf(stderr, "kernel_launch: memset of barrier words failed\n"); return; }
    Params p{};
    for (int i = 0; i < 24; ++i) p.in[i] = (const float*)d_in[i];
    p.out = (float*)d_out; p.ws = (unsigned char*)d_ws;
    void* args[] = {&p};
    hipError_t e = hipLaunchCooperativeKernel((const void*)mega_fwd, dim3(grid), dim3(512), args, LDS_TOTAL, stream);
    if (e != hipSuccess) fprintf(stderr, "kernel_launch: cooperative launch failed: %s (grid %d)\n", hipGetErrorString(e), grid);
}
```
